# Optimizing an MI355X kernel written in HIP

```python
import jax, jax.numpy as jnp
from jax import lax
import numpy as np

D_MODEL = 1024
BATCH = 2
SEQ = 8192
DEPTH = 1

CHUNK = 64
N_PAST_CHUNKS = 8
BAND = (N_PAST_CHUNKS + 1) * CHUNK
ATT_HEADS = 8
ATT_HEAD_DIM = 64
ATT_WIDTH = ATT_HEADS * ATT_HEAD_DIM
MAX_REL = 256
N_REL = 2 * MAX_REL + 1
DN_HEADS = 4
DN_HEAD_DIM = 128
DN_WIDTH = DN_HEADS * DN_HEAD_DIM
CONV_K = 4
D_FF = 4 * D_MODEL
EPS = 1e-6
SPLITS = [ATT_WIDTH, 2 * ATT_WIDTH, 3 * ATT_WIDTH,
          3 * ATT_WIDTH + 3 * DN_WIDTH,
          3 * ATT_WIDTH + 4 * DN_WIDTH,
          3 * ATT_WIDTH + 4 * DN_WIDTH + DN_HEADS]
IN_COLS = 3 * ATT_WIDTH + 4 * DN_WIDTH + 2 * DN_HEADS

kernel_name = "hymba_chunkattn_gdn_hybrid"


def rms_norm(x, g):
    xf = x.astype(jnp.float32)
    y = xf * lax.rsqrt(jnp.mean(xf * xf, axis=-1, keepdims=True) + EPS)
    return (y * g.astype(jnp.float32)).astype(x.dtype)


def l2_norm(x):
    xf = x.astype(jnp.float32)
    return xf * lax.rsqrt(jnp.sum(xf * xf, axis=-1, keepdims=True) + EPS)


def chunked_rel_attention(q, k, v, q_gain, k_gain, rel_bias):
    B, L, H, Dh = q.shape
    nc = L // CHUNK
    q = rms_norm(q, q_gain)
    k = rms_norm(k, k_gain)
    qc = q.reshape(B, nc, CHUNK, H, Dh)
    pad = ((0, 0), (N_PAST_CHUNKS * CHUNK, 0), (0, 0), (0, 0))
    kp = jnp.pad(k, pad).reshape(B, nc + N_PAST_CHUNKS, CHUNK, H, Dh)
    vp = jnp.pad(v, pad).reshape(B, nc + N_PAST_CHUNKS, CHUNK, H, Dh)
    kb = jnp.concatenate([kp[:, j:j + nc] for j in range(N_PAST_CHUNKS + 1)], axis=2)
    vb = jnp.concatenate([vp[:, j:j + nc] for j in range(N_PAST_CHUNKS + 1)], axis=2)
    scores = jnp.einsum('bcqhd,bckhd->bchqk', qc, kb,
                        preferred_element_type=jnp.float32) * (Dh ** -0.5)
    q_pos = N_PAST_CHUNKS * CHUNK + np.arange(CHUNK)
    k_pos = np.arange(BAND)
    rel_idx = np.clip(q_pos[:, None] - k_pos[None, :], -MAX_REL, MAX_REL) + MAX_REL
    bias = rel_bias.astype(jnp.float32)[:, rel_idx]
    scores = scores + bias[None, None]
    key_chunk = jnp.arange(nc)[:, None] + jnp.asarray(k_pos // CHUNK)[None, :] - N_PAST_CHUNKS
    valid = key_chunk >= 0
    scores = jnp.where(valid[None, :, None, None, :], scores, jnp.finfo(jnp.float32).min)
    p = jax.nn.softmax(scores, axis=-1).astype(v.dtype)
    o = jnp.einsum('bchqk,bckhd->bcqhd', p, vb)
    return o.reshape(B, L, H * Dh)


def causal_short_conv(x, w):
    L = x.shape[1]
    xp = jnp.pad(x, ((0, 0), (CONV_K - 1, 0), (0, 0)))
    y = xp[:, 0:L] * w[0]
    for j in range(1, CONV_K):
        y = y + xp[:, j:j + L] * w[j]
    return jax.nn.silu(y)


def gated_delta_rule(q, k, v, g, beta):
    B, L, H, Dk = q.shape
    Dv = v.shape[-1]
    nc = L // CHUNK
    f32 = jnp.float32
    q = l2_norm(q) * (Dk ** -0.5)
    k = l2_norm(k)
    v = v.astype(f32)

    def to_chunks(t):
        return jnp.transpose(t.reshape(B, nc, CHUNK, H, -1), (0, 3, 1, 2, 4))

    q, k, v = to_chunks(q), to_chunks(k), to_chunks(v)
    g = jnp.transpose(g.astype(f32).reshape(B, nc, CHUNK, H), (0, 3, 1, 2))
    beta = jnp.transpose(beta.astype(f32).reshape(B, nc, CHUNK, H), (0, 3, 1, 2))
    decay = jnp.cumsum(g, axis=-1)
    tril = jnp.asarray(np.tril(np.ones((CHUNK, CHUNK), dtype=bool)))
    strict = jnp.asarray(np.tril(np.ones((CHUNK, CHUNK), dtype=bool), -1))
    diff = decay[..., :, None] - decay[..., None, :]
    l_mask = jnp.where(tril, jnp.exp(jnp.where(tril, diff, 0.0)), 0.0)
    k_beta = k * beta[..., None]
    v_beta = v * beta[..., None]
    a_strict = jnp.where(strict, jnp.einsum('bhnid,bhnjd->bhnij', k_beta, k) * l_mask, 0.0)
    t_mat = a_strict + jnp.eye(CHUNK, dtype=f32)
    value = lax.linalg.triangular_solve(t_mat, v_beta, left_side=True, lower=True,
                                        unit_diagonal=True)
    k_cumdecay = lax.linalg.triangular_solve(t_mat, k_beta * jnp.exp(decay)[..., None],
                                             left_side=True, lower=True, unit_diagonal=True)
    attn_intra = jnp.where(tril, jnp.einsum('bhnid,bhnjd->bhnij', q, k) * l_mask, 0.0)
    q_decay = q * jnp.exp(decay)[..., None]
    k_tail = k * jnp.exp(decay[..., -1:] - decay)[..., None]
    chunk_decay = jnp.exp(decay[..., -1])

    def step(S, inp):
        qd, kc, val, att, kt, cd = inp
        v_new = val - jnp.einsum('bhcd,bhde->bhce', kc, S)
        o = jnp.einsum('bhcd,bhde->bhce', qd, S) + jnp.einsum('bhij,bhje->bhie', att, v_new)
        S = S * cd[..., None, None] + jnp.einsum('bhcd,bhce->bhde', kt, v_new)
        return S, o

    xs = tuple(jnp.moveaxis(t, 2, 0) for t in
               (q_decay, k_cumdecay, value, attn_intra, k_tail, chunk_decay))
    S0 = jnp.zeros((B, H, Dk, Dv), f32)
    _, o = lax.scan(step, S0, xs)
    return jnp.transpose(o, (1, 0, 3, 2, 4)).reshape(B, L, H, Dv)


def setup_inputs(seed: int = 0) -> dict:
    key = jax.random.key(seed)
    ks = jax.random.split(key, 16)
    f32 = jnp.float32

    def nrm(k, shape, s):
        return jax.random.normal(k, shape, f32) * s

    x = nrm(ks[0], (BATCH, SEQ, D_MODEL), 1.0)
    mix_norm_gain = 1.0 + nrm(ks[1], (DEPTH, D_MODEL), 0.05)
    w_in = nrm(ks[2], (DEPTH, D_MODEL, IN_COLS), D_MODEL ** -0.5)
    att_q_gain = 1.0 + nrm(ks[3], (DEPTH, ATT_HEAD_DIM), 0.05)
    att_k_gain = 1.0 + nrm(ks[4], (DEPTH, ATT_HEAD_DIM), 0.05)
    rel_bias = nrm(ks[5], (DEPTH, ATT_HEADS, N_REL), 0.2)
    att_out_gain = 1.0 + nrm(ks[6], (DEPTH, ATT_WIDTH), 0.05)
    dn_conv_w = nrm(ks[7], (DEPTH, CONV_K, 3 * DN_WIDTH), CONV_K ** -0.5)
    dn_a_log = jnp.log(jax.random.uniform(ks[8], (DEPTH, DN_HEADS), f32, 1.0, 16.0))
    dt = jnp.exp(jax.random.uniform(ks[9], (DEPTH, DN_HEADS), f32,
                                    float(np.log(1e-3)), float(np.log(1e-1))))
    dn_dt_bias = dt + jnp.log(-jnp.expm1(-dt))
    dn_out_gain = 1.0 + nrm(ks[10], (DEPTH, DN_HEAD_DIM), 0.05)
    w_out = nrm(ks[11], (DEPTH, D_MODEL, D_MODEL), D_MODEL ** -0.5)
    ffn_norm_gain = 1.0 + nrm(ks[12], (DEPTH, D_MODEL), 0.05)
    w_ff1 = nrm(ks[13], (DEPTH, D_MODEL, D_FF), D_MODEL ** -0.5)
    w_ff2 = nrm(ks[14], (DEPTH, D_FF, D_MODEL), D_FF ** -0.5)
    return {"x": x, "mix_norm_gain": mix_norm_gain, "w_in": w_in,
            "att_q_gain": att_q_gain, "att_k_gain": att_k_gain, "rel_bias": rel_bias,
            "att_out_gain": att_out_gain, "dn_conv_w": dn_conv_w, "dn_a_log": dn_a_log,
            "dn_dt_bias": dn_dt_bias, "dn_out_gain": dn_out_gain, "w_out": w_out,
            "ffn_norm_gain": ffn_norm_gain, "w_ff1": w_ff1, "w_ff2": w_ff2}


def reference(x, mix_norm_gain, w_in, att_q_gain, att_k_gain, rel_bias, att_out_gain,
              dn_conv_w, dn_a_log, dn_dt_bias, dn_out_gain, w_out, ffn_norm_gain,
              w_ff1, w_ff2):
    B, L, _ = x.shape
    h = x
    for layer in range(DEPTH):
        u = rms_norm(h, mix_norm_gain[layer])
        proj = u @ w_in[layer]
        aq, ak, av, dqkv, dgate, da, db = jnp.split(proj, SPLITS, axis=-1)
        shp_a = (B, L, ATT_HEADS, ATT_HEAD_DIM)
        o_att = chunked_rel_attention(aq.reshape(shp_a), ak.reshape(shp_a), av.reshape(shp_a),
                                      att_q_gain[layer], att_k_gain[layer], rel_bias[layer])
        o_att = rms_norm(o_att, att_out_gain[layer])
        dqkv = causal_short_conv(dqkv, dn_conv_w[layer])
        dq, dk, dv = jnp.split(dqkv, 3, axis=-1)
        shp_d = (B, L, DN_HEADS, DN_HEAD_DIM)
        log_decay = -jnp.exp(dn_a_log[layer].astype(jnp.float32)) * jax.nn.softplus(
            da.astype(jnp.float32) + dn_dt_bias[layer].astype(jnp.float32))
        beta = jax.nn.sigmoid(db.astype(jnp.float32))
        o_dn = gated_delta_rule(dq.reshape(shp_d), dk.reshape(shp_d), dv.reshape(shp_d),
                                log_decay, beta)
        o_dn = rms_norm(o_dn, dn_out_gain[layer]) * jax.nn.silu(
            dgate.reshape(shp_d).astype(jnp.float32))
        o_dn = o_dn.reshape(B, L, DN_WIDTH).astype(h.dtype)
        mixed = jnp.concatenate([o_att, o_dn], axis=-1) @ w_out[layer]
        h = h + mixed
        z = rms_norm(h, ffn_norm_gain[layer]) @ w_ff1[layer]
        h = h + jnp.square(jax.nn.relu(z)) @ w_ff2[layer]
    return h
```

```cpp
#include <hip/hip_runtime.h>
#include <cstdio>
#include <cstdint>
namespace pg8 {
#define PG8_LAS __attribute__((address_space(3)))
typedef unsigned short bf16_t;
typedef short bf16x8 __attribute__((ext_vector_type(8)));
typedef float f32x4 __attribute__((ext_vector_type(4)));
typedef unsigned u32x4 __attribute__((ext_vector_type(4)));
constexpr int BM = 256, BK = 64, HALF = 128, HTB = HALF * BK * 2  , STAGE_BYTES = 8 * HTB, NXCD = 8, WGM = 4;

__host__ __device__ __forceinline__ int lds_byte(int r, int c) { const int st = (r >> 4) * 2 + (c >> 5), rr = r & 15, cc = c & 31, ob = rr * 64 + cc * 2; return st * 1024 + (ob ^ (((ob >> 9) & 1) << 5)); }
__host__ __device__ __forceinline__ void stage_rc(int b, int& R, int& C) { const int st = b / 1024, sb = b % 1024, swz = sb ^ (((sb >> 9) & 1) << 5); R = (st >> 1) * 16 + swz / 64; C = (st & 1) * 32 + (swz % 64) / 2; }
__host__ __device__ __forceinline__ int perm32(int rho) { const int n = rho >> 4, i = rho & 15; return 8 * (i >> 2) + 4 * n + (i & 3); }

struct Unit { int pm, pn; };
struct Gemm { const bf16_t* A; const bf16_t* Bt; int M, N, K; };

struct StaticOrder {
    int nM, nN, nwg, G, c;
    __host__ __device__ void init(int M, int N, int G_, int c_) { nM = M / BM; nN = N / BM; nwg = nM * nN; G = G_; c = c_; }
    __host__ __device__ bool next(int i, Unit& u) const {
        const long L = (long)i * G + c; if (L >= nwg) return false;
        int wgid = (int)L; { const int q = nwg / NXCD, r = nwg % NXCD, xcd = wgid % NXCD, off = wgid / NXCD; wgid = (xcd < r ? xcd * (q + 1) : r * (q + 1) + (xcd - r) * q) + off; }
        const int nig = WGM * nN, gid = wgid / nig, fm = gid * WGM, gsz = (nM - fm) < WGM ? (nM - fm) : WGM;
        u.pm = fm + ((wgid % nig) % gsz); u.pn = (wgid % nig) / gsz; return true;
    }
    __device__ __forceinline__ void a_ready(const Unit&) const {}
    __device__ __forceinline__ void done(const Unit&) const {}
};

__device__ __forceinline__ unsigned cvt_pk_bf16(float lo, float hi) { unsigned r; asm volatile("v_cvt_pk_bf16_f32 %0, %1, %2" : "=v"(r) : "v"(lo), "v"(hi)); return r; }
typedef float f32x2 __attribute__((ext_vector_type(2)));
__device__ __forceinline__ f32x2 gelu_pk(f32x2 v) {
    const f32x2 av = __builtin_elementwise_abs(v), d = av * 0.2316418882f + 1.0f;
    f32x2 t; t.x = __builtin_amdgcn_rcpf(d.x); t.y = __builtin_amdgcn_rcpf(d.y);
    f32x2 q = t * 0.5307027145f + (-0.7265760135f); q = q * t + 0.7107068705f; q = q * t + (-0.142248368f); q = q * t + 0.127414796f; q = q * t;
    const f32x2 s = (v * v) * (-0.72134752044f);
    f32x2 e; e.x = __builtin_amdgcn_exp2f(s.x); e.y = __builtin_amdgcn_exp2f(s.y);
    const f32x2 m = v * (q * e), r = v - m;
    f32x2 o; o.x = v.x < 0.f ? m.x : r.x; o.y = v.y < 0.f ? m.y : r.y; return o;
}

template <int ACT  > struct EpiBf16 {
    static constexpr bool PERM = true, AFTER_DRAIN = false; static_assert(ACT == 0 || ACT == 1, "EpiBf16: ACT is 0 (none) or 1 (gelu_pk)");
    bf16_t* O; int ldc; const float* bias; int split_cols; size_t split_stride; float scale0;
    __device__ __forceinline__ void operator()(const f32x4 (&acc)[2][2][4][2], const Unit& u, int wr, int wc, int fr, int fq) const {
        const int row0 = u.pm * BM + wr * 64 + fr; int colt = u.pn * BM; bf16_t* base = O;
        float sc = 1.f; if (split_cols) { const int t = colt / split_cols; base += (size_t)t * split_stride; colt -= t * split_cols; if (t == 0) sc = scale0; }
        const int col0 = colt + wc * 32 + 8 * fq, bcol0 = u.pn * BM + wc * 32 + 8 * fq;
        f32x4 bv[2][2];
#pragma unroll
        for (int bj = 0; bj < 2; ++bj)
#pragma unroll
            for (int n = 0; n < 2; ++n) bv[bj][n] = bias ? *(const f32x4*)(bias + bcol0 + bj * HALF + 4 * n) : (f32x4){0.f, 0.f, 0.f, 0.f};
#pragma unroll
        for (int ai = 0; ai < 2; ++ai)
#pragma unroll
            for (int m = 0; m < 4; ++m) { bf16_t* rowp = base + (size_t)(row0 + ai * HALF + m * 16) * ldc + col0;
#pragma unroll
                for (int bj = 0; bj < 2; ++bj) { f32x4 v0 = acc[ai][bj][m][0] + bv[bj][0], v1 = acc[ai][bj][m][1] + bv[bj][1];
                    if (ACT == 1) { f32x2 a = gelu_pk((f32x2){v0[0], v0[1]}), b = gelu_pk((f32x2){v0[2], v0[3]}), c = gelu_pk((f32x2){v1[0], v1[1]}), d = gelu_pk((f32x2){v1[2], v1[3]});
                        v0 = (f32x4){a.x, a.y, b.x, b.y}; v1 = (f32x4){c.x, c.y, d.x, d.y}; }
                    v0 = v0 * sc; v1 = v1 * sc; u32x4 w; w.x = cvt_pk_bf16(v0[0], v0[1]); w.y = cvt_pk_bf16(v0[2], v0[3]); w.z = cvt_pk_bf16(v1[0], v1[1]); w.w = cvt_pk_bf16(v1[2], v1[3]);
                    *(u32x4*)(rowp + bj * HALF) = w; } }
    }
};

template <class Epi, class Sched, bool ALIGN_EPI = false, bool SP2 = false>
__device__ __forceinline__ void gemm_phase(PG8_LAS unsigned char* lds, const Gemm g, const Sched& S, const Epi& E) {
    const int tid = threadIdx.x, wid = __builtin_amdgcn_readfirstlane(tid >> 6), lane = tid & 63, wr = wid >> 2, wc = wid & 3, fr = lane & 15, fq = lane >> 4;
    const int K = g.K, nt = K / BK;
    unsigned voffA[2], voffB[2];
#pragma unroll
    for (int i = 0; i < 2; ++i) { int R, C; stage_rc(tid * 16 + i * 8192, R, C); const int Rb = Epi::PERM ? ((R & ~31) + perm32(R & 31)) : R;
        voffA[i] = (unsigned)(R * K + C) * 2u; voffB[i] = (unsigned)(Rb * K + C) * 2u; }
    const size_t kstep = (size_t)(BK * 2);
    const size_t hstep = (size_t)HALF * K * 2;
    const size_t tstep = 2 * hstep;
    const unsigned ldsw = (unsigned)wid * 1024u;
    const int aoff = lds_byte(wr * 64 + fr, fq * 8), boff = lds_byte(wc * 32 + fr, fq * 8);
#define PG8_SA(b, h) (((b) * 2 + (h)) * HTB)
#define PG8_SB(b, h) ((4 + (b) * 2 + (h)) * HTB)
#define PG8_STAGE(bufoff, gbase, voff) do { _Pragma("unroll") for (int _i = 0; _i < 2; ++_i) \
        __builtin_amdgcn_global_load_lds((const unsigned*)((const char*)(gbase) + (voff)[_i]), (PG8_LAS unsigned*)(lds + (bufoff) + ldsw + _i * 8192), 16, 0, 0); } while (0)
#define PG8_LDA(dst, b, h) do { _Pragma("unroll") for (int m = 0; m < 4; ++m) _Pragma("unroll") for (int k = 0; k < 2; ++k) dst[m][k] = *(const PG8_LAS bf16x8*)(lds + PG8_SA(b, h) + aoff + m * 2048 + k * 1024); } while (0)
#define PG8_LDB(dst, b, h) do { _Pragma("unroll") for (int n = 0; n < 2; ++n) _Pragma("unroll") for (int k = 0; k < 2; ++k) dst[n][k] = *(const PG8_LAS bf16x8*)(lds + PG8_SB(b, h) + boff + n * 2048 + k * 1024); } while (0)
#define PG8_MMA(ai, bj, At, Bt) do { __builtin_amdgcn_s_setprio(1); _Pragma("unroll") for (int m = 0; m < 4; ++m) _Pragma("unroll") for (int n = 0; n < 2; ++n) _Pragma("unroll") for (int k = 0; k < 2; ++k) \
        acc[ai][bj][m][n] = __builtin_amdgcn_mfma_f32_16x16x32_bf16(Bt[n][k], At[m][k], acc[ai][bj][m][n], 0, 0, 0); __builtin_amdgcn_s_setprio(0); } while (0)
#define PG8_WAIT_V(n) asm volatile("s_waitcnt vmcnt(" #n ")" ::: "memory")
#define PG8_WAIT_L(n) asm volatile("s_waitcnt lgkmcnt(" #n ")" ::: "memory")
#define PG8_BAR __builtin_amdgcn_s_barrier()
#define PG8_SCHED __builtin_amdgcn_sched_barrier(0)
    Unit cur, nxt; int ui = 0;
    if (!S.next(0, cur)) return;
    f32x4 acc[2][2][4][2];
#pragma unroll
    for (int a = 0; a < 2; ++a)
#pragma unroll
        for (int b = 0; b < 2; ++b)
#pragma unroll
            for (int m = 0; m < 4; ++m)
#pragma unroll
                for (int n = 0; n < 2; ++n) acc[a][b][m][n] = (f32x4){0.f, 0.f, 0.f, 0.f};
    bf16x8 At[4][2], B0[2][2], B1[2][2];
    const char* cA = (const char*)g.A + (size_t)cur.pm * tstep; const char* cB = (const char*)g.Bt + (size_t)cur.pn * tstep;
    S.a_ready(cur);
    if constexpr (SP2) {
        PG8_STAGE(PG8_SB(0, 0), cB, voffB); PG8_STAGE(PG8_SB(0, 1), cB + hstep, voffB); PG8_STAGE(PG8_SA(0, 0), cA, voffA); PG8_STAGE(PG8_SA(0, 1), cA + hstep, voffA);
        if (wr == 1) PG8_BAR;
        PG8_WAIT_V(2); PG8_BAR;
        PG8_STAGE(PG8_SB(1, 0), cB + kstep, voffB); PG8_STAGE(PG8_SA(1, 0), cA + kstep, voffA); PG8_STAGE(PG8_SB(1, 1), cB + hstep + kstep, voffB);
        PG8_WAIT_V(6); PG8_BAR;
    } else {
        PG8_STAGE(PG8_SB(0, 0), cB, voffB); PG8_STAGE(PG8_SA(0, 0), cA, voffA); PG8_STAGE(PG8_SB(0, 1), cB + hstep, voffB); PG8_STAGE(PG8_SA(0, 1), cA + hstep, voffA);
        if (wr == 1) PG8_BAR;
        PG8_WAIT_V(4); PG8_BAR;
        PG8_STAGE(PG8_SB(1, 0), cB + kstep, voffB); PG8_STAGE(PG8_SA(1, 0), cA + kstep, voffA); PG8_STAGE(PG8_SB(1, 1), cB + hstep + kstep, voffB);
        PG8_WAIT_V(6); PG8_BAR;
    }
    for (;;) {
        const bool has_next = S.next(ui + 1, nxt);
        const char* nA = has_next ? (const char*)g.A + (size_t)nxt.pm * tstep : cA; const char* nB = has_next ? (const char*)g.Bt + (size_t)nxt.pn * tstep : cB;
        for (int t = 0; t < nt; t += 2) {
            const bool last = (t == nt - 2);
            const char* a1 = cA + (size_t)(t + 1) * kstep;
            const char* a2 = last ? nA : cA + (size_t)(t + 2) * kstep; const char* b2 = last ? nB : cB + (size_t)(t + 2) * kstep;
            const char* a3 = a2 + kstep; const char* b3 = b2 + kstep;
            if (last && has_next) S.a_ready(nxt);
            if constexpr (SP2) {
            PG8_LDB(B0, 0, 0); PG8_LDB(B1, 0, 1); PG8_SCHED; PG8_LDA(At, 0, 0); PG8_STAGE(PG8_SA(1, 1), a1 + hstep, voffA);
            PG8_WAIT_V(8); PG8_WAIT_L(0); PG8_BAR; PG8_MMA(0, 0, At, B0); PG8_MMA(0, 1, At, B1); PG8_BAR; PG8_SCHED;
            PG8_LDA(At, 0, 1); PG8_STAGE(PG8_SB(0, 0), b2, voffB); PG8_STAGE(PG8_SB(0, 1), b2 + hstep, voffB); PG8_STAGE(PG8_SA(0, 0), a2, voffA);
            PG8_WAIT_V(8); PG8_WAIT_L(0); PG8_BAR; PG8_MMA(1, 0, At, B0); PG8_MMA(1, 1, At, B1); PG8_BAR; PG8_SCHED;
            PG8_LDB(B0, 1, 0); PG8_LDB(B1, 1, 1); PG8_SCHED; PG8_LDA(At, 1, 0); PG8_STAGE(PG8_SA(0, 1), a2 + hstep, voffA);
            PG8_WAIT_V(8); PG8_WAIT_L(0); PG8_BAR; PG8_MMA(0, 0, At, B0); PG8_MMA(0, 1, At, B1); PG8_BAR; PG8_SCHED;
            PG8_LDA(At, 1, 1); PG8_STAGE(PG8_SB(1, 0), b3, voffB); PG8_STAGE(PG8_SB(1, 1), b3 + hstep, voffB); PG8_STAGE(PG8_SA(1, 0), a3, voffA);
            PG8_WAIT_V(8); PG8_WAIT_L(0); PG8_BAR; PG8_MMA(1, 0, At, B0); PG8_MMA(1, 1, At, B1); PG8_BAR; PG8_SCHED;
            } else {
            PG8_LDB(B0, 0, 0); PG8_SCHED; PG8_LDA(At, 0, 0); PG8_STAGE(PG8_SA(1, 1), a1 + hstep, voffA);
            PG8_WAIT_L(8); PG8_BAR; PG8_WAIT_L(0); PG8_MMA(0, 0, At, B0); PG8_BAR; PG8_SCHED;
            PG8_LDB(B1, 0, 1); PG8_STAGE(PG8_SB(0, 0), b2, voffB);
            PG8_BAR; PG8_WAIT_L(0); PG8_MMA(0, 1, At, B1); PG8_BAR;
            PG8_LDA(At, 0, 1); PG8_STAGE(PG8_SA(0, 0), a2, voffA);
            PG8_BAR; PG8_WAIT_L(0); PG8_MMA(1, 0, At, B0); PG8_BAR; PG8_SCHED;
            PG8_STAGE(PG8_SB(0, 1), b2 + hstep, voffB);
            PG8_WAIT_V(6); PG8_BAR; PG8_MMA(1, 1, At, B1); PG8_BAR;
            PG8_LDB(B0, 1, 0); PG8_SCHED; PG8_LDA(At, 1, 0); PG8_STAGE(PG8_SA(0, 1), a2 + hstep, voffA);
            PG8_WAIT_L(8); PG8_BAR; PG8_WAIT_L(0); PG8_MMA(0, 0, At, B0); PG8_BAR; PG8_SCHED;
            PG8_LDB(B1, 1, 1); PG8_STAGE(PG8_SB(1, 0), b3, voffB);
            PG8_BAR; PG8_WAIT_L(0); PG8_MMA(0, 1, At, B1); PG8_BAR;
            PG8_LDA(At, 1, 1); PG8_STAGE(PG8_SA(1, 0), a3, voffA);
            PG8_BAR; PG8_WAIT_L(0); PG8_MMA(1, 0, At, B0); PG8_BAR; PG8_SCHED;
            PG8_STAGE(PG8_SB(1, 1), b3 + hstep, voffB);
            PG8_WAIT_V(6); PG8_BAR; PG8_MMA(1, 1, At, B1); PG8_BAR;
            }
        }
        if constexpr (ALIGN_EPI) { if (wr == 0) PG8_BAR; }
        if constexpr (!Epi::AFTER_DRAIN) { E(acc, cur, wr, wc, fr, fq); S.done(cur); }
        if (!has_next) break;
#pragma unroll
        for (int a = 0; a < 2; ++a)
#pragma unroll
            for (int b = 0; b < 2; ++b)
#pragma unroll
                for (int m = 0; m < 4; ++m)
#pragma unroll
                    for (int n = 0; n < 2; ++n) acc[a][b][m][n] = (f32x4){0.f, 0.f, 0.f, 0.f};
        cur = nxt; cA = nA; cB = nB; ++ui;
        if constexpr (ALIGN_EPI) { if (wr == 1) PG8_BAR; }
    }
    PG8_WAIT_V(0);
    if constexpr (!ALIGN_EPI) { if (wr == 0) PG8_BAR; }
    PG8_BAR;
    if constexpr (Epi::AFTER_DRAIN) { E.fused(acc, cur, wr, wc, fr, fq, lds, wid, lane); S.done(cur); }
#undef PG8_SA
#undef PG8_SB
#undef PG8_STAGE
#undef PG8_LDA
#undef PG8_LDB
#undef PG8_MMA
#undef PG8_WAIT_V
#undef PG8_WAIT_L
#undef PG8_BAR
#undef PG8_SCHED
}
}

#include <hip/hip_cooperative_groups.h>
namespace cg = cooperative_groups;
#define LAS __attribute__((address_space(3)))
typedef unsigned short bf16;
typedef float f32x4 __attribute__((ext_vector_type(4)));
typedef float f32x2v __attribute__((ext_vector_type(2)));
typedef unsigned u32x2 __attribute__((ext_vector_type(2)));
typedef unsigned u32x4 __attribute__((ext_vector_type(4)));
typedef short bf16x8 __attribute__((ext_vector_type(8)));

constexpr int BATCH = 2, SEQ = 8192, M = BATCH * SEQ, D = 1024, NPROJ = 3584, INCOLS = 3592, FF = 4096;
constexpr int NCH = SEQ / 64;
constexpr float EPS = 1e-6f;
constexpr int NTHR = 512, NWAVES = 8;

constexpr size_t MiB = 1u << 20;
constexpr size_t WS_CTL = 0, CTL_BYTES = 1 * MiB;
constexpr size_t WS_WIN = 2 * MiB, WS_WOUT = 10 * MiB, WS_W1 = 12 * MiB, WS_W2 = 20 * MiB, WS_GB = 28 * MiB, WS_SSQ = 29 * MiB;
constexpr size_t WS_XN = 32 * MiB;
constexpr size_t WS_PROJ = 64 * MiB;
constexpr size_t WS_MIX = 176 * MiB;
constexpr size_t WS_OATT = 208 * MiB;
constexpr size_t WS_ODN = 224 * MiB;
constexpr size_t WS_Z = 64 * MiB;
constexpr size_t WS_END = 256 * MiB;

constexpr int LDS_BYTES = 163840;

__device__ __forceinline__ unsigned f2bf(float f) { unsigned u = __builtin_bit_cast(unsigned, f); return (u + 0x7fffu + ((u >> 16) & 1u)) >> 16; }
__device__ __forceinline__ unsigned pk2(float lo, float hi) { return f2bf(lo) | (f2bf(hi) << 16); }
__device__ __forceinline__ float bflo(unsigned w) { return __builtin_bit_cast(float, w << 16); }
__device__ __forceinline__ float bfhi(unsigned w) { return __builtin_bit_cast(float, w & 0xffff0000u); }
__device__ __forceinline__ float bf2f(bf16 b) { return __builtin_bit_cast(float, (unsigned)b << 16); }
__device__ __forceinline__ float wave_sum(float v) {
#pragma unroll
    for (int o = 1; o < 64; o <<= 1) v += __shfl_xor(v, o);
    return v;
}
typedef float f32x2_t __attribute__((ext_vector_type(2))); typedef __bf16 bf16x2_t __attribute__((ext_vector_type(2)));
__device__ __forceinline__ unsigned cvtpk(float lo, float hi) { f32x2_t v = {lo, hi}; bf16x2_t b = __builtin_convertvector(v, bf16x2_t); return __builtin_bit_cast(unsigned, b); }
__device__ __forceinline__ bf16x8 pack8(const f32x4& a, const f32x4& b) { u32x4 p; p.x = cvtpk(a[0], a[1]); p.y = cvtpk(a[2], a[3]); p.z = cvtpk(b[0], b[1]); p.w = cvtpk(b[2], b[3]); return __builtin_bit_cast(bf16x8, p); }
__device__ __forceinline__ unsigned short f2bf_hw(float x) { return (unsigned short)(cvtpk(x, x) & 0xffffu); }
__device__ __forceinline__ float fexp(float x) { return __builtin_amdgcn_exp2f(x * 1.4426950408889634f); }
__device__ __forceinline__ float frcp(float x) { return __builtin_amdgcn_rcpf(x); }
__device__ __forceinline__ float frsq(float x) { return __builtin_amdgcn_rsqf(x); }
__device__ __forceinline__ float silu_f(float y) { return y * frcp(1.0f + fexp(-y)); }

struct Args {
    const float* in[15]; float* out; unsigned char* ws; int ph_lo, ph_hi;
};

namespace pg8 {
struct EpiResid {
    static constexpr bool PERM = false, AFTER_DRAIN = false;
    const float* base; float* out; bf16_t* hb; float* ssq; int ldc;
    __device__ __forceinline__ void operator()(const f32x4 (&acc)[2][2][4][2], const Unit& u, int wr, int wc, int fr, int fq) const {
        typedef unsigned u32x2v __attribute__((ext_vector_type(2)));
        const int col0 = u.pn * BM + wc * 32 + 4 * fq;
#pragma unroll
        for (int ai = 0; ai < 2; ++ai)
#pragma unroll
            for (int mp = 0; mp < 2; ++mp) {
                f32x4 bs[2][2][2];
#pragma unroll
                for (int mm = 0; mm < 2; ++mm) { const size_t off = (size_t)(u.pm * BM + ai * HALF + wr * 64 + (2 * mp + mm) * 16 + fr) * ldc + col0;
#pragma unroll
                    for (int bj = 0; bj < 2; ++bj)
#pragma unroll
                        for (int n = 0; n < 2; ++n) bs[mm][bj][n] = *(const f32x4*)(base + off + bj * HALF + n * 16); }
                asm volatile("" ::: "memory");
#pragma unroll
                for (int mm = 0; mm < 2; ++mm) { const int m = 2 * mp + mm; const int r = u.pm * BM + ai * HALF + wr * 64 + m * 16 + fr; const size_t off = (size_t)r * ldc + col0; float s = 0.f;
#pragma unroll
                    for (int bj = 0; bj < 2; ++bj)
#pragma unroll
                        for (int n = 0; n < 2; ++n) {
                            const f32x4 o = bs[mm][bj][n] + acc[ai][bj][m][n];
                            if (out) *(f32x4*)(out + off + bj * HALF + n * 16) = o;
                            s += (o[0] * o[0] + o[1] * o[1]) + (o[2] * o[2] + o[3] * o[3]);
                            if (hb) { u32x2v w; w.x = cvt_pk_bf16(o[0], o[1]); w.y = cvt_pk_bf16(o[2], o[3]); *(u32x2v*)(hb + off + bj * HALF + n * 16) = w; }
                        }
                    if (ssq) { s += __shfl_xor(s, 16); s += __shfl_xor(s, 32); if (fq == 0) ssq[(size_t)r * 16 + u.pn * 4 + wc] = s; } }
                asm volatile("" ::: "memory");
            }
    }
};
struct EpiRelu2 {
    static constexpr bool PERM = true, AFTER_DRAIN = false;
    bf16_t* O; int ldc; const float* ssq; float inv_ncol, eps;
    __device__ __forceinline__ void operator()(const f32x4 (&acc)[2][2][4][2], const Unit& u, int wr, int wc, int fr, int fq) const {
        const int row0 = u.pm * BM + wr * 64 + fr; const int col0 = u.pn * BM + wc * 32 + 8 * fq;
        float rsv[2][4];
#pragma unroll
        for (int ai = 0; ai < 2; ++ai)
#pragma unroll
            for (int m = 0; m < 4; ++m) {
                const f32x4* sp = (const f32x4*)(ssq + (size_t)(row0 + ai * HALF + m * 16) * 16);
                const f32x4 s0 = sp[0], s1 = sp[1], s2 = sp[2], s3 = sp[3];
                const float tot = ((s0[0] + s0[1]) + (s0[2] + s0[3])) + ((s1[0] + s1[1]) + (s1[2] + s1[3])) + ((s2[0] + s2[1]) + (s2[2] + s2[3])) + ((s3[0] + s3[1]) + (s3[2] + s3[3]));
                rsv[ai][m] = __builtin_amdgcn_rsqf(tot * inv_ncol + eps);
            }
        asm volatile("" ::: "memory");
#pragma unroll
        for (int ai = 0; ai < 2; ++ai)
#pragma unroll
            for (int m = 0; m < 4; ++m) {
                const float rs = rsv[ai][m];
                bf16_t* rowp = O + (size_t)(row0 + ai * HALF + m * 16) * ldc + col0;
#pragma unroll
                for (int bj = 0; bj < 2; ++bj) {
                    f32x4 v0 = acc[ai][bj][m][0] * rs, v1 = acc[ai][bj][m][1] * rs;
#pragma unroll
                    for (int e = 0; e < 4; ++e) { const float a = fmaxf(v0[e], 0.f), b = fmaxf(v1[e], 0.f); v0[e] = a * a; v1[e] = b * b; }
                    u32x4 w; w.x = cvt_pk_bf16(v0[0], v0[1]); w.y = cvt_pk_bf16(v0[2], v0[3]); w.z = cvt_pk_bf16(v1[0], v1[1]); w.w = cvt_pk_bf16(v1[2], v1[3]);
                    *(u32x4*)(rowp + bj * HALF) = w;
                }
            }
    }
};
struct EpiOutBf {
    static constexpr bool PERM = false, AFTER_DRAIN = false;
    const bf16_t* hb; float* out; int ldc;
    __device__ __forceinline__ void operator()(const f32x4 (&acc)[2][2][4][2], const Unit& u, int wr, int wc, int fr, int fq) const {
        typedef unsigned u32x2v __attribute__((ext_vector_type(2)));
        const int col0 = u.pn * BM + wc * 32 + 4 * fq;
#pragma unroll
        for (int ai = 0; ai < 2; ++ai) {
            u32x2v w[4][2][2];
#pragma unroll
            for (int m = 0; m < 4; ++m) { const size_t off = (size_t)(u.pm * BM + ai * HALF + wr * 64 + m * 16 + fr) * ldc + col0;
#pragma unroll
                for (int bj = 0; bj < 2; ++bj)
#pragma unroll
                    for (int n = 0; n < 2; ++n) w[m][bj][n] = *(const u32x2v*)(hb + off + bj * HALF + n * 16); }
            asm volatile("" ::: "memory");
#pragma unroll
            for (int m = 0; m < 4; ++m) { const size_t off = (size_t)(u.pm * BM + ai * HALF + wr * 64 + m * 16 + fr) * ldc + col0;
#pragma unroll
                for (int bj = 0; bj < 2; ++bj)
#pragma unroll
                    for (int n = 0; n < 2; ++n) {
                        const u32x2v ww = w[m][bj][n];
                        f32x4 bs; bs[0] = __builtin_bit_cast(float, ww.x << 16); bs[1] = __builtin_bit_cast(float, ww.x & 0xffff0000u); bs[2] = __builtin_bit_cast(float, ww.y << 16); bs[3] = __builtin_bit_cast(float, ww.y & 0xffff0000u);
                        *(f32x4*)(out + off + bj * HALF + n * 16) = bs + acc[ai][bj][m][n];
                    } }
            asm volatile("" ::: "memory");
        }
    }
};
}

struct Frame {
    LAS unsigned char* lds;
    int tid, lane, wave, G, gw, NGW;
    const float *x, *mix_gain, *w_in, *q_gain, *k_gain, *rel_bias, *att_out_gain, *conv_w, *a_log, *dt_bias, *dn_out_gain, *w_out, *ffn_gain, *w1, *w2;
    float* out;
    bf16 *WIN_T, *WOUT_T, *W1_T, *W2_T, *XN, *H1B, *PROJ, *MIX, *OATT, *Z, *WKI, *UI, *SnI, *QdI, *AttI, *TinvI;
    float *GB, *SSQ, *CD;
};

__device__ __forceinline__ void transpose_item(const float* W, int ldw, int K, int ncols, const float* kgain, bf16* WT, LAS float* scr, int item, int lane) {
    const int nblk = ncols / 32, kb = item / nblk, nb = item % nblk, k0 = 64 * kb, n0 = 32 * nb;
#pragma unroll
    for (int i = 0; i < 32; ++i) { const int kk = 2 * i + (lane >> 5); float w = W[(size_t)(k0 + kk) * ldw + n0 + (lane & 31)]; if (kgain) w *= kgain[k0 + kk]; scr[kk * 33 + (lane & 31)] = w; }
    asm volatile("s_waitcnt lgkmcnt(0)" ::: "memory");
    const int c = lane & 7;
#pragma unroll
    for (int j = 0; j < 4; ++j) { const int n = (lane >> 3) + 8 * j; const LAS float* s = scr + (8 * c) * 33 + n;
        u32x4 o; o.x = cvtpk(s[0 * 33], s[1 * 33]); o.y = cvtpk(s[2 * 33], s[3 * 33]); o.z = cvtpk(s[4 * 33], s[5 * 33]); o.w = cvtpk(s[6 * 33], s[7 * 33]);
        *(u32x4*)(WT + (size_t)(n0 + n) * K + k0 + 8 * c) = o; }
    asm volatile("s_waitcnt lgkmcnt(0)" ::: "memory");
}

__device__ __forceinline__ void weights_rest(Frame& F, int wv, int nwv) {
    LAS float* scr = (LAS float*)(F.lds + F.wave * 8448);
    constexpr int I_O = (D / 64) * (D / 32), I_1 = (D / 64) * (FF / 32), I_2 = (FF / 64) * (D / 32);
    for (int it = wv; it < I_O + I_1 + I_2; it += nwv) {
        int r = it;
        if (r < I_O) { transpose_item(F.w_out, D, D, D, nullptr, F.WOUT_T, scr, r, F.lane); continue; } r -= I_O;
        if (r < I_1) { transpose_item(F.w1, FF, D, FF, F.ffn_gain, F.W1_T, scr, r, F.lane); continue; } r -= I_1;
        transpose_item(F.w2, D, FF, D, nullptr, F.W2_T, scr, r, F.lane);
    }
}

__device__ __forceinline__ void p0_row(Frame& F, int r, const f32x4 (&v)[4], const f32x4 (&gq)[4], const LAS float* w8, float dtb, float ealg, int ccol) {
    const int lane = F.lane;
    float ss = 0.f;
#pragma unroll
    for (int j = 0; j < 4; ++j) ss += (v[j][0] * v[j][0] + v[j][1] * v[j][1]) + (v[j][2] * v[j][2] + v[j][3] * v[j][3]);
    ss = wave_sum(ss);
    const float rstd = frsq(ss * (1.0f / D) + EPS);
    float ds[8];
#pragma unroll
    for (int c = 0; c < 8; ++c) ds[c] = 0.f;
#pragma unroll
    for (int j = 0; j < 4; ++j) {
        const f32x4 u = v[j] * rstd * gq[j];
        u32x2 w; w.x = cvtpk(u[0], u[1]); w.y = cvtpk(u[2], u[3]);
        *(u32x2*)(F.XN + (size_t)r * D + 256 * j + 4 * lane) = w;
#pragma unroll
        for (int e = 0; e < 4; ++e) {
            const int k = 256 * j + 4 * lane + e;
            const f32x4 w0 = *(const LAS f32x4*)(w8 + k * 8), w1 = *(const LAS f32x4*)(w8 + k * 8 + 4);
#pragma unroll
            for (int c = 0; c < 4; ++c) { ds[c] += u[e] * w0[c]; ds[4 + c] += u[e] * w1[c]; }
        }
    }
    const bool b5 = (lane & 32) != 0, b4 = (lane & 16) != 0, b3 = (lane & 8) != 0;
    float e4[4], e2[2];
#pragma unroll
    for (int c = 0; c < 4; ++c) { const float snd = b5 ? ds[c] : ds[4 + c], kp = b5 ? ds[4 + c] : ds[c]; e4[c] = kp + __shfl_xor(snd, 32); }
#pragma unroll
    for (int c = 0; c < 2; ++c) { const float snd = b4 ? e4[c] : e4[2 + c], kp = b4 ? e4[2 + c] : e4[c]; e2[c] = kp + __shfl_xor(snd, 16); }
    float d;
    { const float snd = b3 ? e2[0] : e2[1], kp = b3 ? e2[1] : e2[0]; d = kp + __shfl_xor(snd, 8); }
    d += __shfl_xor(d, 4); d += __shfl_xor(d, 2); d += __shfl_xor(d, 1);
    if ((lane & 7) == 0) {
        float val;
        if (ccol < 4) { const float a = d + dtb; const float sp = fmaxf(a, 0.f) + __builtin_amdgcn_logf(1.0f + fexp(-fabsf(a))) * 0.6931471805599453f; val = -ealg * sp; }
        else val = frcp(1.0f + fexp(-d));
        F.GB[(size_t)r * 8 + ccol] = val;
    }
}

__device__ __forceinline__ void p0_prologue(Frame& F) {
    LAS float* w8 = (LAS float*)(F.lds + 69632);
#pragma unroll
    for (int q = 0; q < 16; ++q) { const int i = F.tid + q * NTHR; w8[i] = F.w_in[(size_t)(i >> 3) * INCOLS + NPROJ + (i & 7)]; }
    __syncthreads();
    const int lane = F.lane;
    f32x4 gq[4];
#pragma unroll
    for (int j = 0; j < 4; ++j) gq[j] = ((const f32x4*)F.mix_gain)[lane + 64 * j];
    const int ccol = ((lane >> 5) & 1) * 4 + ((lane >> 4) & 1) * 2 + ((lane >> 3) & 1);
    const float dtb = F.dt_bias[ccol & 3], ealg = expf(F.a_log[ccol & 3]);
#define P0_LOAD(buf, rr) do { if ((rr) < M) { _Pragma("unroll") for (int j = 0; j < 4; ++j) buf[j] = ((const f32x4*)(F.x + (size_t)(rr) * D) + lane)[64 * j]; } } while (0)
    f32x4 xa[4], xb[4], xc[4];
    P0_LOAD(xa, F.gw); P0_LOAD(xb, F.gw + F.NGW); P0_LOAD(xc, F.gw + 2 * F.NGW);
    for (int r = F.gw; r < M; r += 3 * F.NGW) {
        p0_row(F, r, xa, gq, w8, dtb, ealg, ccol); P0_LOAD(xa, r + 3 * F.NGW);
        if (r + F.NGW < M) { p0_row(F, r + F.NGW, xb, gq, w8, dtb, ealg, ccol); P0_LOAD(xb, r + 4 * F.NGW); }
        if (r + 2 * F.NGW < M) { p0_row(F, r + 2 * F.NGW, xc, gq, w8, dtb, ealg, ccol); P0_LOAD(xc, r + 5 * F.NGW); }
    }
#undef P0_LOAD
    LAS float* scr = (LAS float*)(F.lds + F.wave * 8448);
    constexpr int I_IN = (D / 64) * (NPROJ / 32);
    for (int it = F.gw; it < I_IN; it += F.NGW) transpose_item(F.w_in, INCOLS, D, NPROJ, nullptr, F.WIN_T, scr, it, lane);
    if (F.G != 256) weights_rest(F, F.gw, F.NGW);
}

#define LDSBAR() asm volatile("s_waitcnt lgkmcnt(0)\n\ts_barrier" ::: "memory")
#define MFMA16(a, b, c) __builtin_amdgcn_mfma_f32_16x16x32_bf16((a), (b), (c), 0, 0, 0)

constexpr int PST = 132;
constexpr int AST = 68;
__device__ __forceinline__ bf16x8 ld8cvt(const LAS float* p) { const f32x4 a = *(const LAS f32x4*)p, b = *(const LAS f32x4*)(p + 4); return pack8(a, b); }
__device__ __forceinline__ void dn_prep_unit(Frame& F, int unit) {
    const int n = unit & 127, bh = unit >> 7, h = bh & 3, b = bh >> 2;
    const int tid = F.tid, lane = F.lane, wave = F.wave;
    const size_t row0 = (size_t)b * SEQ + (size_t)n * 64;
    LAS float* qf = (LAS float*)F.lds;
    LAS float* kf = qf + 64 * PST;
    LAS float* vf = kf + 64 * PST;
    LAS float* Am = vf + 64 * PST;
    LAS float* An = Am + 64 * AST;
    LAS float* dL = An + 64 * AST;
    LAS float* bL = dL + 64;
    LAS bf16* AttL = (LAS bf16*)(bL + 64);
    if (tid < 384) {
        const int rg = tid / 48, cc = tid - rg * 48, mat = cc >> 4, c8 = (cc & 15) * 8, ch = mat * 512 + h * 128 + c8;
        const bf16* src = F.PROJ + (row0 + 8 * rg) * NPROJ + 1536 + ch;
        u32x4 raw[11];
#pragma unroll
        for (int i = 0; i < 11; ++i) {
            if (i < 3 && n == 0 && rg == 0) raw[i] = (u32x4){0u, 0u, 0u, 0u};
            else raw[i] = *(const u32x4*)(src + ((ptrdiff_t)i - 3) * (ptrdiff_t)NPROJ);
        }
        f32x4 wa[4], wb[4];
#pragma unroll
        for (int j = 0; j < 4; ++j) { wa[j] = *(const f32x4*)(F.conv_w + j * 1536 + ch); wb[j] = *(const f32x4*)(F.conv_w + j * 1536 + ch + 4); }
        LAS float* dst = qf + mat * (64 * PST) + (8 * rg) * PST + c8;
        const float qsc = (mat == 0) ? 0.08838834764831845f : 1.0f;
        f32x4 ya[8], yb[8]; float ss[8];
#pragma unroll
        for (int i = 0; i < 8; ++i) {
            ya[i] = (f32x4){0.f, 0.f, 0.f, 0.f}; yb[i] = (f32x4){0.f, 0.f, 0.f, 0.f};
#pragma unroll
            for (int j = 0; j < 4; ++j) {
                const u32x4 w = raw[i + j];
                ya[i] += wa[j] * (f32x4){bflo(w.x), bfhi(w.x), bflo(w.y), bfhi(w.y)};
                yb[i] += wb[j] * (f32x4){bflo(w.z), bfhi(w.z), bflo(w.w), bfhi(w.w)};
            }
#pragma unroll
            for (int e = 0; e < 4; ++e) { ya[i][e] = silu_f(ya[i][e]); yb[i][e] = silu_f(yb[i][e]); }
            ss[i] = (ya[i][0] * ya[i][0] + ya[i][1] * ya[i][1]) + (ya[i][2] * ya[i][2] + ya[i][3] * ya[i][3]) + (yb[i][0] * yb[i][0] + yb[i][1] * yb[i][1]) + (yb[i][2] * yb[i][2] + yb[i][3] * yb[i][3]);
        }
        if (mat < 2) {
#pragma unroll
            for (int o = 1; o < 16; o <<= 1) {
                float t[8];
#pragma unroll
                for (int i = 0; i < 8; ++i) t[i] = __shfl_xor(ss[i], o);
#pragma unroll
                for (int i = 0; i < 8; ++i) ss[i] += t[i];
            }
#pragma unroll
            for (int i = 0; i < 8; ++i) { const float sc = frsq(ss[i] + EPS) * qsc; ya[i] = ya[i] * sc; yb[i] = yb[i] * sc; }
        }
#pragma unroll
        for (int i = 0; i < 8; ++i) { *(LAS f32x4*)(dst + i * PST) = ya[i]; *(LAS f32x4*)(dst + i * PST + 4) = yb[i]; }
    } else if (wave == 7) {
#pragma unroll 8
        for (int row = 0; row < 64; ++row) Am[row * AST + lane] = (row == lane) ? 1.0f : 0.0f;
    } else if (wave == 6) {
        float v = F.GB[(row0 + lane) * 8 + h];
#pragma unroll
        for (int o = 1; o < 64; o <<= 1) { const float t = __shfl_up(v, o); if (lane >= o) v += t; }
        dL[lane] = v; bL[lane] = F.GB[(row0 + lane) * 8 + 4 + h];
    }
    LDSBAR();
    {
        const int c = lane & 15, g = lane >> 4, mi = wave >> 1, nj0 = 2 * (wave & 1);
        bf16x8 ak[4], aq[4];
#pragma unroll
        for (int kk = 0; kk < 4; ++kk) { ak[kk] = ld8cvt(kf + (16 * mi + c) * PST + 32 * kk + 8 * g); aq[kk] = ld8cvt(qf + (16 * mi + c) * PST + 32 * kk + 8 * g); }
#pragma unroll
        for (int t = 0; t < 2; ++t) {
            const int nj = nj0 + t;
            f32x4 kk4 = {0.f, 0.f, 0.f, 0.f}, qk4 = {0.f, 0.f, 0.f, 0.f};
#pragma unroll
            for (int kk = 0; kk < 4; ++kk) { const bf16x8 bb = ld8cvt(kf + (16 * nj + c) * PST + 32 * kk + 8 * g); kk4 = MFMA16(ak[kk], bb, kk4); qk4 = MFMA16(aq[kk], bb, qk4); }
            const int j = 16 * nj + c; const float dj = dL[j];
#pragma unroll
            for (int e = 0; e < 4; ++e) {
                const int i = 16 * mi + 4 * g + e; const float di = dL[i], bi = bL[i];
                const float ex = fexp(fminf(di - dj, 0.f));
                const float aij = (j < i) ? bi * kk4[e] * ex : 0.f;
                An[i * AST + j] = aij;
                AttL[i * 64 + j] = (bf16)f2bf_hw((j <= i) ? qk4[e] * ex : 0.f);
            }
        }
    }
    LDSBAR();
    {
        LAS float* Ti = Am;
        const float dlast = dL[63];
        if (wave == 0) {
            const int cl = lane & 15, g = lane >> 4;
#pragma unroll
            for (int b4 = 0; b4 < 4; ++b4) {
                const int i0 = 16 * b4;
                if (b4 > 0) {
                    f32x4 acc3[3] = {{0.f, 0.f, 0.f, 0.f}, {0.f, 0.f, 0.f, 0.f}, {0.f, 0.f, 0.f, 0.f}};
#pragma unroll
                    for (int ks = 0; ks < (b4 == 3 ? 2 : 1); ++ks) {
                        const bool valid = (32 * ks + 8 * g) < i0;
                        const LAS float* ap = An + (i0 + cl) * AST + 32 * ks + 8 * g;
                        f32x4 a0 = *(const LAS f32x4*)ap, a1 = *(const LAS f32x4*)(ap + 4);
                        if (!valid) { a0 = (f32x4){0.f, 0.f, 0.f, 0.f}; a1 = a0; }
                        const bf16x8 Ah = pack8(a0, a1);
#pragma unroll
                        for (int ct = 0; ct < 3; ++ct) if (ct < b4) {
                            const LAS float* xp = Ti + (32 * ks + 8 * g) * AST + 16 * ct + cl;
                            f32x4 x0, x1;
#pragma unroll
                            for (int jj = 0; jj < 4; ++jj) { x0[jj] = xp[jj * AST]; x1[jj] = xp[(4 + jj) * AST]; }
                            acc3[ct] = MFMA16(Ah, pack8(x0, x1), acc3[ct]);
                        }
                    }
#pragma unroll
                    for (int ct = 0; ct < 3; ++ct) if (ct < b4) {
                        LAS float* rp = Ti + (i0 + 4 * g) * AST + 16 * ct + cl;
#pragma unroll
                        for (int e = 0; e < 4; ++e) rp[e * AST] -= acc3[ct][e];
                    }
                }
                LAS float* X = Ti + i0 * AST + lane;
                float x[16];
                f32x4 ac[16][4];
#pragma unroll
                for (int r = 0; r < 16; ++r) x[r] = X[r * AST];
#pragma unroll
                for (int r = 1; r < 16; ++r)
#pragma unroll
                    for (int q4 = 0; q4 < (r + 3) / 4; ++q4) ac[r][q4] = *(const LAS f32x4*)(An + (i0 + r) * AST + i0 + 4 * q4);
                __builtin_amdgcn_sched_barrier(0);
#pragma unroll
                for (int r = 1; r < 16; ++r)
#pragma unroll
                    for (int q4 = 0; q4 < (r + 3) / 4; ++q4)
#pragma unroll
                        for (int e = 0; e < 4; ++e) if (4 * q4 + e < r) x[r] -= ac[r][q4][e] * x[4 * q4 + e];
#pragma unroll
                for (int r = 0; r < 16; ++r) X[r * AST] = x[r];
            }
        } else {
            const int t7 = tid - 64;
#pragma unroll 1
            for (int idx = t7; idx < 1024; idx += 448) {
                const int f = idx >> 6, l = idx & 63, r = l & 15, g = l >> 4, m = f >> 2, s = f & 3, tok = 16 * m + r;
                const float e = fexp(dL[tok]); const LAS float* sp = qf + tok * PST + 32 * s + 4 * g;
                const f32x4 lo = *(const LAS f32x4*)sp * e, hi = *(const LAS f32x4*)(sp + 16) * e;
                *(bf16x8*)(F.QdI + (size_t)unit * 8192 + (size_t)idx * 8) = pack8(lo, hi);
            }
#pragma unroll 1
            for (int idx = t7; idx < 1024; idx += 448) {
                const int f = idx >> 6, l = idx & 63, r = l & 15, g = l >> 4, m = f >> 2, s = f & 3, tok = 16 * m + r;
                const float e = -bL[tok] * fexp(dL[tok]); const LAS float* sp = kf + tok * PST + 32 * s + 4 * g;
                const f32x4 lo = *(const LAS f32x4*)sp * e, hi = *(const LAS f32x4*)(sp + 16) * e;
                *(bf16x8*)(F.WKI + (size_t)unit * 16384 + (size_t)idx * 8) = pack8(lo, hi);
            }
#pragma unroll 1
            for (int idx = t7; idx < 1024; idx += 448) {
                const int f = idx >> 6, l = idx & 63, r = l & 15, g = l >> 4, T = f >> 1, s2 = f & 1, dk = 16 * T + r;
                float v[8];
#pragma unroll
                for (int j = 0; j < 8; ++j) { const int tok = 32 * s2 + 16 * (j >> 2) + 4 * g + (j & 3); v[j] = kf[tok * PST + dk] * fexp(dlast - dL[tok]); }
                u32x4 o; o.x = cvtpk(v[0], v[1]); o.y = cvtpk(v[2], v[3]); o.z = cvtpk(v[4], v[5]); o.w = cvtpk(v[6], v[7]);
                *(u32x4*)(F.WKI + (size_t)unit * 16384 + 8192 + (size_t)idx * 8) = o;
            }
#pragma unroll 1
            for (int idx = t7; idx < 1024; idx += 448) {
                const int f = idx >> 6, l = idx & 63, c = l & 15, g = l >> 4, w = f >> 1, s2 = f & 1, dv = 16 * w + c;
                float v[8];
#pragma unroll
                for (int j = 0; j < 8; ++j) { const int tok = 32 * s2 + 16 * (j >> 2) + 4 * g + (j & 3); v[j] = vf[tok * PST + dv] * bL[tok]; }
                u32x4 o; o.x = cvtpk(v[0], v[1]); o.y = cvtpk(v[2], v[3]); o.z = cvtpk(v[4], v[5]); o.w = cvtpk(v[6], v[7]);
                *(u32x4*)(F.UI + (size_t)unit * 8192 + (size_t)idx * 8) = o;
            }
#pragma unroll 1
            for (int idx = t7; idx < 512; idx += 448) {
                const int f = idx >> 6, l = idx & 63, r = l & 15, g = l >> 4, m = f >> 1, s2 = f & 1, tok = 16 * m + r;
                const LAS bf16* sp = AttL + tok * 64 + 32 * s2 + 4 * g;
                const u32x2 lo = *(const LAS u32x2*)sp, hi = *(const LAS u32x2*)(sp + 16);
                u32x4 o; o.x = lo.x; o.y = lo.y; o.z = hi.x; o.w = hi.y;
                *(u32x4*)(F.AttI + (size_t)unit * 4096 + (size_t)idx * 8) = o;
            }
            if (t7 == 0) F.CD[unit] = fexp(dlast);
        }
        LDSBAR();
        {
            const int idx = tid, f = idx >> 6, l = idx & 63, r = l & 15, g = l >> 4, m = f >> 1, s2 = f & 1, tok = 16 * m + r;
            const LAS float* sp = Ti + tok * AST + 32 * s2 + 4 * g;
            const f32x4 lo = *(const LAS f32x4*)sp, hi = *(const LAS f32x4*)(sp + 16);
            *(bf16x8*)(F.TinvI + (size_t)unit * 4096 + (size_t)idx * 8) = pack8(lo, hi);
        }
    }
    LDSBAR();
}

__device__ __forceinline__ void dn_scan(Frame& F, int sblk) {
    constexpr int STG = 38 * 1024;
    const int bh = sblk >> 2, qd = sblk & 3, wave = F.wave, lane = F.lane;
    const bf16* WK = F.WKI + (size_t)bh * 128 * 16384;
    if (wave >= 4) {
        const int lw = wave - 4;
        const bf16* TQ = F.TinvI + (size_t)bh * 128 * 4096;
#define SCAN_ISSUE(nn) do { _Pragma("unroll") for (int q_ = 0; q_ < 10; ++q_) { const int f_ = lw + 4 * q_; if (f_ < 38) { \
            const int tf_ = f_ - 32, gt_ = (tf_ < 3) ? 2 * tf_ : tf_ + 2;                   \
            const bf16* src_ = (f_ < 32) ? (WK + (size_t)(nn) * 16384 + f_ * 512) : (TQ + (size_t)(nn) * 4096 + gt_ * 512); \
            __builtin_amdgcn_global_load_lds((const unsigned*)(src_ + lane * 8), (LAS unsigned*)(F.lds + ((nn) & 3) * STG + f_ * 1024), 16, 0, 0); } } } while (0)
        SCAN_ISSUE(0); SCAN_ISSUE(1); SCAN_ISSUE(2);
        if (lw < 2) asm volatile("s_waitcnt vmcnt(20)" ::: "memory"); else asm volatile("s_waitcnt vmcnt(18)" ::: "memory");
        __builtin_amdgcn_s_barrier();
#pragma unroll 1
        for (int n = 0; n < NCH; ++n) {
            if (n + 3 < NCH) { SCAN_ISSUE(n + 3); if (lw < 2) asm volatile("s_waitcnt vmcnt(20)" ::: "memory"); else asm volatile("s_waitcnt vmcnt(18)" ::: "memory"); }
            else asm volatile("s_waitcnt vmcnt(0)" ::: "memory");
            __builtin_amdgcn_s_barrier();
        }
#undef SCAN_ISSUE
    } else if (wave < 2) {
        const int w = 2 * qd + wave;
        bf16* UIb = F.UI + (size_t)bh * 128 * 8192 + w * 1024 + lane * 8;
        bf16* SnIb = F.SnI + (size_t)bh * 128 * 16384 + w * 2048 + lane * 8;
        const float cdv0 = F.CD[bh * 128 + lane], cdv1 = F.CD[bh * 128 + 64 + lane];
        f32x4 Sacc[8];
#pragma unroll
        for (int T = 0; T < 8; ++T) Sacc[T] = (f32x4){0.f, 0.f, 0.f, 0.f};
#define SCAN_LD(B0, B1, nn) do { const int n_ = ((nn) < NCH) ? (nn) : NCH - 1; B0 = *(const u32x4*)(UIb + (size_t)n_ * 8192); B1 = *(const u32x4*)(UIb + (size_t)n_ * 8192 + 512); } while (0)
#define SCAN_STEP(nq, u0, u1) do { const int n = (nq); \
            bf16x8 Sb[4]; \
            _Pragma("unroll") for (int s = 0; s < 4; ++s) { Sb[s] = pack8(Sacc[2 * s], Sacc[2 * s + 1]); *(bf16x8*)(SnIb + (size_t)n * 16384 + s * 512) = Sb[s]; } \
            const float cd = __builtin_bit_cast(float, __builtin_amdgcn_readlane(__builtin_bit_cast(int, (n < 64) ? cdv0 : cdv1), n & 63)); \
            const LAS unsigned char* slot = F.lds + (n & 3) * STG + lane * 16; \
            f32x4 Yacc[4]; \
            Yacc[0] = (f32x4){bflo(u0.x), bfhi(u0.x), bflo(u0.y), bfhi(u0.y)}; Yacc[1] = (f32x4){bflo(u0.z), bfhi(u0.z), bflo(u0.w), bfhi(u0.w)}; \
            Yacc[2] = (f32x4){bflo(u1.x), bfhi(u1.x), bflo(u1.y), bfhi(u1.y)}; Yacc[3] = (f32x4){bflo(u1.z), bfhi(u1.z), bflo(u1.w), bfhi(u1.w)}; \
            _Pragma("unroll") for (int s = 0; s < 4; ++s) \
                _Pragma("unroll") for (int m = 0; m < 4; ++m) { const bf16x8 a = *(const LAS bf16x8*)(slot + (m * 4 + s) * 1024); Yacc[m] = MFMA16(a, Sb[s], Yacc[m]); } \
            bf16x8 Yb[2]; \
            _Pragma("unroll") for (int s2 = 0; s2 < 2; ++s2) Yb[s2] = pack8(Yacc[2 * s2], Yacc[2 * s2 + 1]); \
            f32x4 Vacc[4]; const f32x4 zero4 = {0.f, 0.f, 0.f, 0.f}; \
            Vacc[0] = MFMA16(*(const LAS bf16x8*)(slot + 32 * 1024), Yb[0], zero4); \
            Vacc[1] = MFMA16(*(const LAS bf16x8*)(slot + 33 * 1024), Yb[0], zero4); \
            Vacc[2] = MFMA16(*(const LAS bf16x8*)(slot + 34 * 1024), Yb[0], zero4); Vacc[2] = MFMA16(*(const LAS bf16x8*)(slot + 35 * 1024), Yb[1], Vacc[2]); \
            Vacc[3] = MFMA16(*(const LAS bf16x8*)(slot + 36 * 1024), Yb[0], zero4); Vacc[3] = MFMA16(*(const LAS bf16x8*)(slot + 37 * 1024), Yb[1], Vacc[3]); \
            bf16x8 Vb[2]; \
            _Pragma("unroll") for (int s2 = 0; s2 < 2; ++s2) { Vb[s2] = pack8(Vacc[2 * s2], Vacc[2 * s2 + 1]); *(bf16x8*)(UIb + (size_t)n * 8192 + s2 * 512) = Vb[s2]; } \
            _Pragma("unroll") for (int T = 0; T < 8; ++T) Sacc[T] = Sacc[T] * cd; \
            _Pragma("unroll") for (int s2 = 0; s2 < 2; ++s2) \
                _Pragma("unroll") for (int T = 0; T < 8; ++T) { const bf16x8 a = *(const LAS bf16x8*)(slot + (16 + T * 2 + s2) * 1024); Sacc[T] = MFMA16(a, Vb[s2], Sacc[T]); } \
            asm volatile("s_waitcnt lgkmcnt(0)" ::: "memory"); \
            __builtin_amdgcn_s_barrier(); asm volatile("" ::: "memory"); } while (0)
        u32x4 ua0, ua1, ub0, ub1, uc0, uc1;
        SCAN_LD(ua0, ua1, 0); SCAN_LD(ub0, ub1, 1); SCAN_LD(uc0, uc1, 2);
        __builtin_amdgcn_s_barrier();
        asm volatile("" ::: "memory");
#pragma unroll 1
        for (int n3 = 0; n3 < NCH - 2; n3 += 3) {
            SCAN_STEP(n3, ua0, ua1); SCAN_LD(ua0, ua1, n3 + 3);
            SCAN_STEP(n3 + 1, ub0, ub1); SCAN_LD(ub0, ub1, n3 + 4);
            SCAN_STEP(n3 + 2, uc0, uc1); SCAN_LD(uc0, uc1, n3 + 5);
        }
        SCAN_STEP(NCH - 2, ua0, ua1);
        SCAN_STEP(NCH - 1, ub0, ub1);
#undef SCAN_STEP
#undef SCAN_LD
    } else {
        __builtin_amdgcn_s_barrier();
#pragma unroll 1
        for (int n = 0; n < NCH; ++n) __builtin_amdgcn_s_barrier();
    }
    asm volatile("s_waitcnt vmcnt(0) lgkmcnt(0)" ::: "memory");
    __syncthreads();
}

__device__ __forceinline__ void dn_out_task(Frame& F, int task) {
    const int unit = task >> 2, m = task & 3, n = unit & 127, bh = unit >> 7, h = bh & 3, b = bh >> 2, lane = F.lane, c = lane & 15, g = lane >> 4;
    const size_t row0 = (size_t)b * SEQ + (size_t)n * 64 + 16 * m + 4 * g;
    const bf16* Qd = F.QdI + (size_t)unit * 8192 + (size_t)(m * 4) * 512 + lane * 8; const bf16* At = F.AttI + (size_t)unit * 4096 + (size_t)(m * 2) * 512 + lane * 8;
    const bf16* Sn = F.SnI + (size_t)unit * 16384 + lane * 8; const bf16* Vn = F.UI + (size_t)unit * 8192 + lane * 8;
    bf16x8 aq[4], aa[2], bc[6], bn[6];
#pragma unroll
    for (int s = 0; s < 4; ++s) aq[s] = *(const bf16x8*)(Qd + s * 512);
#pragma unroll
    for (int s2 = 0; s2 < 2; ++s2) aa[s2] = *(const bf16x8*)(At + s2 * 512);
#pragma unroll
    for (int s = 0; s < 4; ++s) bc[s] = *(const bf16x8*)(Sn + s * 512);
#pragma unroll
    for (int s2 = 0; s2 < 2; ++s2) bc[4 + s2] = *(const bf16x8*)(Vn + s2 * 512);
    const bf16* gp = F.PROJ + row0 * NPROJ + 3072 + h * 128 + c;
    bf16 graw[4][8];
#pragma unroll
    for (int i = 0; i < 4; ++i)
#pragma unroll
        for (int w = 0; w < 8; ++w) graw[i][w] = gp[(size_t)i * NPROJ + 16 * w];
    float gnv[8];
#pragma unroll
    for (int w = 0; w < 8; ++w) gnv[w] = F.dn_out_gain[16 * w + c];
    __builtin_amdgcn_sched_barrier(0);
    f32x4 O[8]; float ssq[4] = {0.f, 0.f, 0.f, 0.f};
#pragma unroll
    for (int w = 0; w < 8; ++w) {
        if (w < 7) {
#pragma unroll
            for (int s = 0; s < 4; ++s) bn[s] = *(const bf16x8*)(Sn + (w + 1) * 2048 + s * 512);
#pragma unroll
            for (int s2 = 0; s2 < 2; ++s2) bn[4 + s2] = *(const bf16x8*)(Vn + (w + 1) * 1024 + s2 * 512);
        }
        __builtin_amdgcn_sched_barrier(0);
        f32x4 acc = {0.f, 0.f, 0.f, 0.f};
#pragma unroll
        for (int s = 0; s < 4; ++s) acc = MFMA16(aq[s], bc[s], acc);
#pragma unroll
        for (int s2 = 0; s2 < 2; ++s2) acc = MFMA16(aa[s2], bc[4 + s2], acc);
        O[w] = acc;
#pragma unroll
        for (int i = 0; i < 4; ++i) ssq[i] += acc[i] * acc[i];
#pragma unroll
        for (int q = 0; q < 6; ++q) bc[q] = bn[q];
        __builtin_amdgcn_sched_barrier(0);
    }
    float rs[4];
#pragma unroll
    for (int i = 0; i < 4; ++i) { float sq = ssq[i]; sq += __shfl_xor(sq, 1); sq += __shfl_xor(sq, 2); sq += __shfl_xor(sq, 4); sq += __shfl_xor(sq, 8); rs[i] = frsq(sq * (1.0f / 128) + EPS); }
    bf16* mp = F.MIX + row0 * D + 512 + h * 128 + c;
#pragma unroll
    for (int w = 0; w < 8; ++w)
#pragma unroll
        for (int i = 0; i < 4; ++i) mp[(size_t)i * D + 16 * w] = (bf16)f2bf_hw(O[w][i] * rs[i] * gnv[w] * silu_f(bf2f(graw[i][w])));
}

__device__ __forceinline__ void finalize_att_rows(Frame& F) {
    const int lane = F.lane;
    const f32x4 g0 = *(const f32x4*)(F.att_out_gain + 8 * lane), g1 = *(const f32x4*)(F.att_out_gain + 8 * lane + 4);
    for (int r0 = F.gw; r0 < M; r0 += 4 * F.NGW) {
        u32x4 w[4];
#pragma unroll
        for (int q = 0; q < 4; ++q) { const int r = r0 + q * F.NGW; w[q] = (r < M) ? *(const u32x4*)(F.OATT + (size_t)r * 512 + 8 * lane) : (u32x4){0u, 0u, 0u, 0u}; }
#pragma unroll
        for (int q = 0; q < 4; ++q) {
            const int r = r0 + q * F.NGW;
            float v[8];
#pragma unroll
            for (int e = 0; e < 4; ++e) { v[2 * e] = bflo(w[q][e]); v[2 * e + 1] = bfhi(w[q][e]); }
            float ss = 0.f;
#pragma unroll
            for (int e = 0; e < 8; ++e) ss += v[e] * v[e];
            ss = wave_sum(ss);
            const float rs = frsq(ss * (1.0f / 512) + EPS);
            u32x4 o; o.x = cvtpk(v[0] * rs * g0[0], v[1] * rs * g0[1]); o.y = cvtpk(v[2] * rs * g0[2], v[3] * rs * g0[3]); o.z = cvtpk(v[4] * rs * g1[0], v[5] * rs * g1[1]); o.w = cvtpk(v[6] * rs * g1[2], v[7] * rs * g1[3]);
            if (r < M) *(u32x4*)(F.MIX + (size_t)r * D + 8 * lane) = o;
        }
    }
}

typedef short v4i16_t __attribute__((ext_vector_type(4)));
constexpr float LOG2E = 1.4426950408889634f;
constexpr int ATT_K = 0, ATT_V = 73728, ATT_BIAS = 147456;
__device__ __forceinline__ v4i16_t vtr(const LAS unsigned char* p) { return __builtin_amdgcn_ds_read_tr16_b64_v4i16((LAS v4i16_t*)p); }
__device__ __forceinline__ void attn_store_kv(LAS unsigned char* Ks, LAS unsigned char* Vs, int key, int ch, const u32x4& kw, const u32x4& vw, const f32x4& kg0, const f32x4& kg1) {
    float kv[8];
#pragma unroll
    for (int e = 0; e < 4; ++e) { kv[2 * e] = bflo(kw[e]); kv[2 * e + 1] = bfhi(kw[e]); }
    float ss = 0.f;
#pragma unroll
    for (int e = 0; e < 8; ++e) ss += kv[e] * kv[e];
    ss += __shfl_xor(ss, 1); ss += __shfl_xor(ss, 2); ss += __shfl_xor(ss, 4);
    const float rk = frsq(ss * (1.0f / 64) + EPS);
    u32x4 o; o.x = cvtpk(kv[0] * rk * kg0[0], kv[1] * rk * kg0[1]); o.y = cvtpk(kv[2] * rk * kg0[2], kv[3] * rk * kg0[3]); o.z = cvtpk(kv[4] * rk * kg1[0], kv[5] * rk * kg1[1]); o.w = cvtpk(kv[6] * rk * kg1[2], kv[7] * rk * kg1[3]);
    *(LAS u32x4*)(Ks + key * 128 + ((ch ^ (key & 7)) << 4)) = o;
    *(LAS u32x4*)(Vs + key * 128 + ((((ch >> 1) ^ ((key >> 1) & 3)) << 5) + ((ch & 1) << 4))) = vw;
}
constexpr int ATT_ML = ATT_BIAS + 4 * 324 * 4;
constexpr int ATT_SCR = ATT_ML + 2048;
__device__ __forceinline__ void attn_run(Frame& F, int u0, int cnt) {
    const int tid = F.tid, lane = F.lane, wave = F.wave, cl = lane & 15, g = lane >> 4, qt = wave & 3, kh = wave >> 2;
    LAS unsigned char* Ks = F.lds + ATT_K; LAS unsigned char* Vs = F.lds + ATT_V; LAS float* biasR = (LAS float*)(F.lds + ATT_BIAS); LAS float* mlL = (LAS float*)(F.lds + ATT_ML);
    const int ch = tid & 7, kl = tid >> 3;
    const f32x4 kg0 = *(const f32x4*)(F.k_gain + 8 * ch), kg1 = *(const f32x4*)(F.k_gain + 8 * ch + 4);
    const f32x4 ga = *(const f32x4*)(F.q_gain + 8 * g), gb = *(const f32x4*)(F.q_gain + 8 * g + 4), gc2 = *(const f32x4*)(F.q_gain + 32 + 8 * g), gd = *(const f32x4*)(F.q_gain + 32 + 8 * g + 4);
    int cur_bh = -1;
    u32x4 qn0 = {0u, 0u, 0u, 0u}, qn1 = {0u, 0u, 0u, 0u};
#pragma unroll 1
    for (int k = 0; k < cnt; ++k) {
        const int u = u0 + k, bh = u >> 7, c = u & (NCH - 1), b = bh >> 3, h = bh & 7;
        const size_t row0 = (size_t)b * SEQ + (size_t)c * 64;
        if (bh != cur_bh) {
            cur_bh = bh;
            float mq = 0.f, mk = 0.f, bmax = -1e30f;
#pragma unroll 8
            for (int d = 0; d < 64; ++d) { mq = fmaxf(mq, fabsf(F.q_gain[d])); mk = fmaxf(mk, fabsf(F.k_gain[d])); }
            for (int i = tid; i < 320; i += NTHR) bmax = fmaxf(bmax, F.rel_bias[h * 513 + 193 + i]);
#pragma unroll
            for (int o = 1; o < 64; o <<= 1) bmax = fmaxf(bmax, __shfl_xor(bmax, o));
            if (lane == 0) mlL[wave] = bmax;
            LDSBAR();
#pragma unroll
            for (int w8 = 0; w8 < 8; ++w8) bmax = fmaxf(bmax, mlL[w8]);
            const float M2 = (8.0f * mq * mk + bmax) * LOG2E;
            for (int i = tid; i < 4 * 324; i += NTHR) { const int sidx = i / 324, y = i - sidx * 324; int x = 516 - y + sidx; x = x > 512 ? 512 : x; biasR[i] = F.rel_bias[h * 513 + x] * LOG2E - M2; }
#pragma unroll 9
            for (int j = 0; j < 9; ++j) {
                const int gc = c - 8 + j, key = ((gc + 9) % 9) * 64 + kl;
                u32x4 kw = {0u, 0u, 0u, 0u}, vw = {0u, 0u, 0u, 0u};
                if (gc >= 0) { const bf16* kp = F.PROJ + ((size_t)b * SEQ + (size_t)gc * 64 + kl) * NPROJ + 512 + h * 64 + 8 * ch; kw = *(const u32x4*)kp; vw = *(const u32x4*)(kp + 512); }
                attn_store_kv(Ks, Vs, key, ch, kw, vw, kg0, kg1);
            }
            { const bf16* qp = F.PROJ + (row0 + 16 * qt + cl) * NPROJ + h * 64 + 8 * g; qn0 = *(const u32x4*)qp; qn1 = *(const u32x4*)(qp + 32); }
            LDSBAR();
        }
        const bool has_next = (k + 1 < cnt) && (((u + 1) >> 7) == bh);
        u32x4 nk0 = {0u, 0u, 0u, 0u}, nv0 = nk0;
        const u32x4 q0 = qn0, q1 = qn1;
        if (has_next) {
            const bf16* kp = F.PROJ + ((size_t)b * SEQ + (size_t)(c + 1) * 64 + kl) * NPROJ + 512 + h * 64 + 8 * ch;
            nk0 = *(const u32x4*)kp; nv0 = *(const u32x4*)(kp + 512);
            const bf16* qp = F.PROJ + (row0 + 64 + 16 * qt + cl) * NPROJ + h * 64 + 8 * g; qn0 = *(const u32x4*)qp; qn1 = *(const u32x4*)(qp + 32);
        }
        bf16x8 Bq0, Bq1;
        {
            float qv[16];
#pragma unroll
            for (int e = 0; e < 4; ++e) { qv[2 * e] = bflo(q0[e]); qv[2 * e + 1] = bfhi(q0[e]); qv[8 + 2 * e] = bflo(q1[e]); qv[8 + 2 * e + 1] = bfhi(q1[e]); }
            float ss = 0.f;
#pragma unroll
            for (int e = 0; e < 16; ++e) ss += qv[e] * qv[e];
            ss += __shfl_xor(ss, 16); ss += __shfl_xor(ss, 32);
            const float rq = frsq(ss * (1.0f / 64) + EPS) * (0.125f * LOG2E);
            u32x4 p0, p1;
            p0.x = cvtpk(qv[0] * rq * ga[0], qv[1] * rq * ga[1]); p0.y = cvtpk(qv[2] * rq * ga[2], qv[3] * rq * ga[3]); p0.z = cvtpk(qv[4] * rq * gb[0], qv[5] * rq * gb[1]); p0.w = cvtpk(qv[6] * rq * gb[2], qv[7] * rq * gb[3]);
            p1.x = cvtpk(qv[8] * rq * gc2[0], qv[9] * rq * gc2[1]); p1.y = cvtpk(qv[10] * rq * gc2[2], qv[11] * rq * gc2[3]); p1.z = cvtpk(qv[12] * rq * gd[0], qv[13] * rq * gd[1]); p1.w = cvtpk(qv[14] * rq * gd[2], qv[15] * rq * gd[3]);
            Bq0 = __builtin_bit_cast(bf16x8, p0); Bq1 = __builtin_bit_cast(bf16x8, p1);
        }
        const int s0 = (c + 1) % 9, T0 = 18 * kh;
        const int off0 = (g ^ (cl & 7)) << 4, off1 = ((4 + g) ^ (cl & 7)) << 4;
        const int qi = 16 * qt + cl, sb3 = cl & 3;
        const LAS float* Rs = biasR + sb3 * 324;
        const int base0 = 768 + qi - 4 * g - sb3 - 16 * T0;
        f32x4 st[18];
#pragma unroll
        for (int t = 0; t < 18; ++t) {
            if (t == 14) LDSBAR();
            const int T = T0 + t, j = T >> 2; int sl = s0 + j; sl = sl >= 9 ? sl - 9 : sl;
            const LAS unsigned char* kb = Ks + (sl * 64 + (T & 3) * 16 + cl) * 128;
            const bf16x8 a0 = *(const LAS bf16x8*)(kb + off0), a1 = *(const LAS bf16x8*)(kb + off1);
            int b4 = base0 - 16 * t; b4 = b4 > 516 ? 516 : b4;
            f32x4 z = *(const LAS f32x4*)(Rs + (516 - b4));
            z = MFMA16(a0, Bq0, z); st[t] = MFMA16(a1, Bq1, z);
        }
        if (c < 8) {
#pragma unroll
            for (int t = 0; t < 18; ++t) if (c - 8 + ((T0 + t) >> 2) < 0) st[t] = (f32x4){-1e30f, -1e30f, -1e30f, -1e30f};
        }
        float lsum = 0.f;
#pragma unroll
        for (int t = 0; t < 18; ++t)
#pragma unroll
            for (int i = 0; i < 4; ++i) { const float p = __builtin_amdgcn_exp2f(st[t][i]); st[t][i] = p; lsum += p; }
        lsum += __shfl_xor(lsum, 16); lsum += __shfl_xor(lsum, 32);
        f32x4 o[4];
#pragma unroll
        for (int dt = 0; dt < 4; ++dt) o[dt] = (f32x4){0.f, 0.f, 0.f, 0.f};
        {
            const int q4 = cl >> 2, p4 = cl & 3, sw = (2 * g + (q4 >> 1)) & 3;
#pragma unroll
            for (int ks = 0; ks < 9; ++ks) {
                const int T = T0 + 2 * ks, j = T >> 2; int sl = s0 + j; sl = sl >= 9 ? sl - 9 : sl;
                const LAS unsigned char* vb = Vs + (sl * 64 + (T & 3) * 16 + 4 * g + q4) * 128 + 8 * p4;
                const bf16x8 pb = pack8(st[2 * ks], st[2 * ks + 1]);
#pragma unroll
                for (int dt = 0; dt < 4; ++dt) {
                    const v4i16_t lo = vtr(vb + ((dt ^ sw) << 5)), hi = vtr(vb + 2048 + ((dt ^ sw) << 5));
                    const bf16x8 a = __builtin_shufflevector(lo, hi, 0, 1, 2, 3, 4, 5, 6, 7);
                    o[dt] = MFMA16(a, pb, o[dt]);
                }
            }
        }
        LAS unsigned* scr = (LAS unsigned*)(F.lds + ATT_SCR);
        if (kh == 1) {
#pragma unroll
            for (int dt = 0; dt < 4; ++dt) { scr[(qt * 8 + 2 * dt) * 64 + lane] = cvtpk(o[dt][0], o[dt][1]); scr[(qt * 8 + 2 * dt + 1) * 64 + lane] = cvtpk(o[dt][2], o[dt][3]); }
            mlL[256 + qt * 64 + lane] = lsum;
        }
        LDSBAR();
        if (kh == 0) {
            const float l1 = mlL[256 + qt * 64 + lane];
            const float inv = frcp(lsum + l1);
            bf16* op = F.OATT + (row0 + qi) * 512 + h * 64 + 4 * g;
#pragma unroll
            for (int dt = 0; dt < 4; ++dt) {
                const unsigned w0 = scr[(qt * 8 + 2 * dt) * 64 + lane], w1 = scr[(qt * 8 + 2 * dt + 1) * 64 + lane];
                u32x2 w; w.x = cvtpk((o[dt][0] + bflo(w0)) * inv, (o[dt][1] + bfhi(w0)) * inv); w.y = cvtpk((o[dt][2] + bflo(w1)) * inv, (o[dt][3] + bfhi(w1)) * inv);
                *(u32x2*)(op + 16 * dt) = w;
            }
        }
        if (has_next) attn_store_kv(Ks, Vs, s0 * 64 + kl, ch, nk0, nv0, kg0, kg1);
    }
}
__device__ __forceinline__ void attn_static(Frame& F, int ab, int nab) {
    const int total = BATCH * 8 * NCH;
    int start, cnt;
    if (nab == 224) {
        const int bh = ab / 14, r = ab - bh * 14;
        start = bh * NCH + r * 9 + (r < 2 ? r : 2); cnt = 9 + (r < 2 ? 1 : 0);
    } else {
        const int base = total / nab, rem = total % nab;
        start = ab * base + (ab < rem ? ab : rem); cnt = base + (ab < rem ? 1 : 0);
    }
    attn_run(F, start, cnt);
}

#define RLX_AGENT __ATOMIC_RELAXED, __HIP_MEMORY_SCOPE_AGENT
#define XB_TMO      128
#define XB_XCNT(j)  (256  + 64 * (j))
#define XB_XSUB(j)  (1280 + 64 * (j))
#define XB_XGEN(j)  (2304 + 64 * (j))
#define XB_TOP      3328
#define XB_TOPGEN   3392
#define XCD_BAR_WORDS 3456
#define XB_SPIN_CAP (1u << 18)

__device__ __forceinline__ unsigned xb_ld(unsigned* p)              { return __hip_atomic_load(p, __ATOMIC_RELAXED, __HIP_MEMORY_SCOPE_AGENT); }
__device__ __forceinline__ unsigned xb_add(unsigned* p, unsigned v) { return __hip_atomic_fetch_add(p, v, __ATOMIC_RELAXED, __HIP_MEMORY_SCOPE_AGENT); }
__device__ __forceinline__ unsigned xb_xcc_id() { return (unsigned)__builtin_amdgcn_s_getreg((3 << 11) | 20) & 0xFu; }
#define XB_SPIN(cond, bar) do { unsigned _sp = 0; while (cond) { __builtin_amdgcn_s_sleep(1); \
    if ((++_sp & 255u) == 0u) { if (xb_ld(&(bar)[XB_TMO])) break; if (_sp > XB_SPIN_CAP) { atomicAdd(&(bar)[XB_TMO], 1u); break; } } } } while (0)

struct XcdBarrier {
    unsigned* bar; unsigned x;
    volatile LAS unsigned* st;
};

__device__ __forceinline__ XcdBarrier xcd_barrier_post(unsigned* bar, volatile LAS unsigned* st) {
    XcdBarrier b; b.bar = bar; b.x = xb_xcc_id(); b.st = st;
    if (threadIdx.x == 0) (void)xb_add(&bar[XB_XCNT(b.x)], 1u);
    return b;
}
__device__ __forceinline__ void xcd_barrier_complete(unsigned* bar, unsigned x, unsigned& nloc, unsigned& nx) {
    const unsigned G = gridDim.x * gridDim.y * gridDim.z;
    unsigned sum, cnt, mine, sp = 0u;
    for (;;) {
        sum = 0u; cnt = 0u; mine = 0u;
#pragma unroll
        for (unsigned j = 0; j < 16; ++j) { const unsigned c = xb_ld(&bar[XB_XCNT(j)]); sum += c; cnt += (c > 0u) ? 1u : 0u; mine = (j == x) ? c : mine; }
        if (sum == G) break;
        __builtin_amdgcn_s_sleep(1);
        if ((++sp & 255u) == 0u) { if (xb_ld(&bar[XB_TMO])) break; if (sp > XB_SPIN_CAP) { atomicAdd(&bar[XB_TMO], 1u); break; } }
    }
    nloc = mine > 0u ? mine : 1u; nx = cnt > 0u ? cnt : 1u;
}

__device__ __forceinline__ void xcd_barrier(const XcdBarrier& b) {
    asm volatile("s_waitcnt vmcnt(0)" ::: "memory");
    __syncthreads();
    if (threadIdx.x == 0) {
        unsigned* bar = b.bar;
        __builtin_amdgcn_s_waitcnt(0);
        unsigned nloc = b.st[0], nx = b.st[1];
        if (nloc == 0u) { xcd_barrier_complete(bar, b.x, nloc, nx); b.st[0] = nloc; b.st[1] = nx; }
        const unsigned old = xb_add(&bar[XB_XSUB(b.x)], 1u);
        const unsigned gen = old / nloc;
        if (old + 1u == (gen + 1u) * nloc) {
            __builtin_amdgcn_fence(__ATOMIC_RELEASE, "agent");
            asm volatile("s_waitcnt vmcnt(0)" ::: "memory");
            const unsigned og = xb_add(&bar[XB_TOP], 1u);
            const unsigned tg = og / nx;
            if (og + 1u == (tg + 1u) * nx) xb_add(&bar[XB_TOPGEN], 1u);
            else XB_SPIN(xb_ld(&bar[XB_TOPGEN]) == tg, bar);
            __builtin_amdgcn_fence(__ATOMIC_ACQUIRE, "agent");
            xb_add(&bar[XB_XGEN(b.x)], 1u);
            asm volatile("s_waitcnt vmcnt(0)" ::: "memory");
        } else {
            XB_SPIN(xb_ld(&bar[XB_XGEN(b.x)]) == gen, bar);
            __builtin_amdgcn_fence(__ATOMIC_ACQUIRE, "agent");
            asm volatile("s_waitcnt vmcnt(0)" ::: "memory");
        }
    }
    __syncthreads();
}

#ifndef PROBE_DUP
#define PROBE_DUP -1
#endif
constexpr int N_PHASES = 8;
__global__ void __launch_bounds__(NTHR, 2) hymba_fwd(Args args) {
    extern __shared__ __attribute__((aligned(16))) unsigned char lds[];
    Frame F;
    F.lds = (LAS unsigned char*)lds;
    F.tid = threadIdx.x; F.lane = F.tid & 63; F.wave = __builtin_amdgcn_readfirstlane(F.tid >> 6);
    F.G = gridDim.x; F.gw = blockIdx.x * NWAVES + F.wave; F.NGW = F.G * NWAVES;
    F.x = args.in[0]; F.mix_gain = args.in[1]; F.w_in = args.in[2]; F.q_gain = args.in[3]; F.k_gain = args.in[4]; F.rel_bias = args.in[5]; F.att_out_gain = args.in[6];
    F.conv_w = args.in[7]; F.a_log = args.in[8]; F.dt_bias = args.in[9]; F.dn_out_gain = args.in[10]; F.w_out = args.in[11]; F.ffn_gain = args.in[12]; F.w1 = args.in[13]; F.w2 = args.in[14];
    F.out = args.out;
    unsigned char* ws = args.ws;
    F.WIN_T = (bf16*)(ws + WS_WIN); F.WOUT_T = (bf16*)(ws + WS_WOUT); F.W1_T = (bf16*)(ws + WS_W1); F.W2_T = (bf16*)(ws + WS_W2);
    F.GB = (float*)(ws + WS_GB); F.SSQ = (float*)(ws + WS_SSQ);
    F.XN = (bf16*)(ws + WS_XN); F.H1B = F.XN; F.WKI = F.XN;
    F.PROJ = (bf16*)(ws + WS_PROJ); F.MIX = (bf16*)(ws + WS_MIX); F.OATT = (bf16*)(ws + WS_OATT); F.Z = (bf16*)(ws + WS_Z);
    F.UI = (bf16*)(ws + WS_ODN); F.CD = (float*)(ws + WS_ODN + 16 * MiB); F.TinvI = (bf16*)(ws + WS_ODN + 24 * MiB);
    F.SnI = (bf16*)args.out; F.QdI = F.SnI + (size_t)16 * MiB; F.AttI = F.SnI + (size_t)24 * MiB;
    volatile LAS unsigned* MISC = (volatile LAS unsigned*)(F.lds + LDS_BYTES - 64);
    if (F.tid < 16) MISC[F.tid] = 0u;
    __syncthreads();
    XcdBarrier bar = xcd_barrier_post((unsigned*)(args.ws + WS_CTL) + 1024, MISC + 8);
    const int lo = args.ph_lo, hi = args.ph_hi;
#define IN(k) (lo <= (k) && (k) < hi)
#define SEAM(k) do { if (IN(k) && IN((k) + 1)) xcd_barrier(bar); } while (0)

    if (IN(0)) { p0_prologue(F); if (PROBE_DUP == 0) { xcd_barrier(bar); p0_prologue(F); } }
    SEAM(0);
    if (PROBE_DUP == 9) { xcd_barrier(bar); xcd_barrier(bar); xcd_barrier(bar); xcd_barrier(bar); }
    if (IN(1)) {
        pg8::Gemm g{F.XN, F.WIN_T, M, NPROJ, D}; pg8::StaticOrder S; S.init(M, NPROJ, F.G, (int)blockIdx.x);
        pg8::EpiBf16<0> E{F.PROJ, NPROJ, nullptr, 0, 0, 1.f};
        pg8::gemm_phase<pg8::EpiBf16<0>, pg8::StaticOrder, true, true>(F.lds, g, S, E);
        if (F.G == 256 && blockIdx.x >= 128) weights_rest(F, ((int)blockIdx.x - 128) * NWAVES + F.wave, 128 * NWAVES);
        if (PROBE_DUP == 1) { xcd_barrier(bar); pg8::gemm_phase<pg8::EpiBf16<0>, pg8::StaticOrder, true, true>(F.lds, g, S, E); }
    }
    SEAM(1);
    if (IN(2)) { for (int u = blockIdx.x; u < 1024; u += F.G) dn_prep_unit(F, u); if (PROBE_DUP == 2) { xcd_barrier(bar); for (int u = blockIdx.x; u < 1024; u += F.G) dn_prep_unit(F, u); } }
    SEAM(2);
    if (IN(3)) { if (PROBE_DUP == 8) { attn_static(F, (int)blockIdx.x, F.G); xcd_barrier(bar); if (blockIdx.x < 32) dn_scan(F, (int)blockIdx.x); } else if (blockIdx.x < 32) dn_scan(F, (int)blockIdx.x); else attn_static(F, (int)blockIdx.x - 32, F.G - 32); if (PROBE_DUP == 3) { xcd_barrier(bar); attn_static(F, (int)blockIdx.x, F.G); } }
    SEAM(3);
    if (IN(4)) { for (int t = F.gw; t < 4096; t += F.NGW) dn_out_task(F, t); finalize_att_rows(F); if (PROBE_DUP == 4) { xcd_barrier(bar); for (int t = F.gw; t < 4096; t += F.NGW) dn_out_task(F, t); finalize_att_rows(F); } }
    SEAM(4);
    if (IN(5)) {
        pg8::Gemm g{F.MIX, F.WOUT_T, M, D, D}; pg8::StaticOrder S; S.init(M, D, F.G, (int)blockIdx.x);
        pg8::EpiResid E{F.x, nullptr, F.H1B, F.SSQ, D};
        pg8::gemm_phase<pg8::EpiResid, pg8::StaticOrder, false, true>(F.lds, g, S, E);
        if (PROBE_DUP == 5) { xcd_barrier(bar); pg8::gemm_phase<pg8::EpiResid, pg8::StaticOrder, false, true>(F.lds, g, S, E); }
    }
    SEAM(5);
    if (IN(6)) {
        pg8::Gemm g{F.H1B, F.W1_T, M, FF, D}; pg8::StaticOrder S; S.init(M, FF, F.G, (int)blockIdx.x);
        pg8::EpiRelu2 E{F.Z, FF, F.SSQ, 1.0f / D, EPS};
        pg8::gemm_phase<pg8::EpiRelu2, pg8::StaticOrder, true, true>(F.lds, g, S, E);
        if (PROBE_DUP == 6) { xcd_barrier(bar); pg8::gemm_phase<pg8::EpiRelu2, pg8::StaticOrder, true, true>(F.lds, g, S, E); }
    }
    SEAM(6);
    if (IN(7)) {
        pg8::Gemm g{F.Z, F.W2_T, M, D, FF}; pg8::StaticOrder S; S.init(M, D, F.G, (int)blockIdx.x);
        pg8::EpiOutBf E{F.H1B, F.out, D};
        pg8::gemm_phase<pg8::EpiOutBf, pg8::StaticOrder, false, true>(F.lds, g, S, E);
    }
#undef IN
#undef SEAM
}

#ifndef MK_N_LAUNCHES
#define MK_N_LAUNCHES 1
#endif
extern "C" void kernel_launch(void* const* d_in, const int* in_sizes, int n_in, void* d_out, int out_size, void* d_ws, size_t ws_size, hipStream_t stream) {
    static int grid = 0;
    if (grid == 0) {
        if (n_in != 15 || in_sizes[0] != M * D || out_size != M * D || ws_size < WS_END) { fprintf(stderr, "kernel_launch: unexpected shapes (n_in %d, in0 %d, out %d, ws %zu); nothing launched\n", n_in, n_in > 0 ? in_sizes[0] : -1, out_size, ws_size); grid = -1; return; }
        int dev = 0, cus = 0, per_cu = 0;
        if (hipGetDevice(&dev) != hipSuccess || hipDeviceGetAttribute(&cus, hipDeviceAttributeMultiprocessorCount, dev) != hipSuccess) { grid = -1; return; }
        if (hipFuncSetAttribute((const void*)hymba_fwd, hipFuncAttributeMaxDynamicSharedMemorySize, LDS_BYTES) != hipSuccess) { fprintf(stderr, "kernel_launch: hipFuncSetAttribute failed\n"); grid = -1; return; }
        if (hipOccupancyMaxActiveBlocksPerMultiprocessor(&per_cu, (const void*)hymba_fwd, NTHR, LDS_BYTES) != hipSuccess || per_cu < 1) { fprintf(stderr, "kernel_launch: occupancy query says %d blocks per CU\n", per_cu); (void)hipGetLastError(); per_cu = 1; }
        grid = cus * (per_cu > 1 ? 1 : per_cu);
        if (grid > 256) grid = 256;
    }
    if (grid < 0) return;
    if (hipMemsetAsync((char*)d_ws + WS_CTL, 0, 65536, stream) != hipSuccess) { fprintf(stderr, "kernel_launch: memset failed\n"); return; }
    Args a{};
    for (int i = 0; i < 15; ++i) a.in[i] = (const float*)d_in[i];
    a.out = (float*)d_out; a.ws = (unsigned char*)d_ws;
#if MK_N_LAUNCHES == 1
    a.ph_lo = 0; a.ph_hi = N_PHASES;
    void* kargs[] = {&a};
    hipError_t e = hipLaunchCooperativeKernel((const void*)hymba_fwd, dim3(grid), dim3(NTHR), kargs, LDS_BYTES, stream);
    if (e != hipSuccess) fprintf(stderr, "kernel_launch: cooperative launch failed: %s (grid %d)\n", hipGetErrorString(e), grid);
#else
    for (int p = 0; p < N_PHASES; ++p) { a.ph_lo = p; a.ph_hi = p + 1; hipLaunchKernelGGL(hymba_fwd, dim3(grid), dim3(NTHR), LDS_BYTES, stream, a); }
#endif
}
```

```cpp
#include <hip/hip_runtime.h>
#include <cstdio>
#include <cstdint>
namespace pg8 {
#define PG8_LAS __attribute__((address_space(3)))
typedef unsigned short bf16_t;
typedef short bf16x8 __attribute__((ext_vector_type(8)));
typedef float f32x4 __attribute__((ext_vector_type(4)));
typedef unsigned u32x4 __attribute__((ext_vector_type(4)));
constexpr int BM = 256, BK = 64, HALF = 128, HTB = HALF * BK * 2  , STAGE_BYTES = 8 * HTB, NXCD = 8, WGM = 4;

__host__ __device__ __forceinline__ int lds_byte(int r, int c) { const int st = (r >> 4) * 2 + (c >> 5), rr = r & 15, cc = c & 31, ob = rr * 64 + cc * 2; return st * 1024 + (ob ^ (((ob >> 9) & 1) << 5)); }
__host__ __device__ __forceinline__ void stage_rc(int b, int& R, int& C) { const int st = b / 1024, sb = b % 1024, swz = sb ^ (((sb >> 9) & 1) << 5); R = (st >> 1) * 16 + swz / 64; C = (st & 1) * 32 + (swz % 64) / 2; }
__host__ __device__ __forceinline__ int perm32(int rho) { const int n = rho >> 4, i = rho & 15; return 8 * (i >> 2) + 4 * n + (i & 3); }

struct Unit { int pm, pn; };
struct Gemm { const bf16_t* A; const bf16_t* Bt; int M, N, K; };

struct StaticOrder {
    int nM, nN, nwg, G, c;
    __host__ __device__ void init(int M, int N, int G_, int c_) { nM = M / BM; nN = N / BM; nwg = nM * nN; G = G_; c = c_; }
    __host__ __device__ bool next(int i, Unit& u) const {
        const long L = (long)i * G + c; if (L >= nwg) return false;
        int wgid = (int)L; { const int q = nwg / NXCD, r = nwg % NXCD, xcd = wgid % NXCD, off = wgid / NXCD; wgid = (xcd < r ? xcd * (q + 1) : r * (q + 1) + (xcd - r) * q) + off; }
        const int nig = WGM * nN, gid = wgid / nig, fm = gid * WGM, gsz = (nM - fm) < WGM ? (nM - fm) : WGM;
        u.pm = fm + ((wgid % nig) % gsz); u.pn = (wgid % nig) / gsz; return true;
    }
    __device__ __forceinline__ void a_ready(const Unit&) const {}
    __device__ __forceinline__ void done(const Unit&) const {}
};

__device__ __forceinline__ unsigned cvt_pk_bf16(float lo, float hi) { unsigned r; asm volatile("v_cvt_pk_bf16_f32 %0, %1, %2" : "=v"(r) : "v"(lo), "v"(hi)); return r; }
typedef float f32x2 __attribute__((ext_vector_type(2)));
__device__ __forceinline__ f32x2 gelu_pk(f32x2 v) {
    const f32x2 av = __builtin_elementwise_abs(v), d = av * 0.2316418882f + 1.0f;
    f32x2 t; t.x = __builtin_amdgcn_rcpf(d.x); t.y = __builtin_amdgcn_rcpf(d.y);
    f32x2 q = t * 0.5307027145f + (-0.7265760135f); q = q * t + 0.7107068705f; q = q * t + (-0.142248368f); q = q * t + 0.127414796f; q = q * t;
    const f32x2 s = (v * v) * (-0.72134752044f);
    f32x2 e; e.x = __builtin_amdgcn_exp2f(s.x); e.y = __builtin_amdgcn_exp2f(s.y);
    const f32x2 m = v * (q * e), r = v - m;
    f32x2 o; o.x = v.x < 0.f ? m.x : r.x; o.y = v.y < 0.f ? m.y : r.y; return o;
}

template <int ACT  > struct EpiBf16 {
    static constexpr bool PERM = true, AFTER_DRAIN = false; static_assert(ACT == 0 || ACT == 1, "EpiBf16: ACT is 0 (none) or 1 (gelu_pk)");
    bf16_t* O; int ldc; const float* bias; int split_cols; size_t split_stride; float scale0;
    __device__ __forceinline__ void operator()(const f32x4 (&acc)[2][2][4][2], const Unit& u, int wr, int wc, int fr, int fq) const {
        const int row0 = u.pm * BM + wr * 64 + fr; int colt = u.pn * BM; bf16_t* base = O;
        float sc = 1.f; if (split_cols) { const int t = colt / split_cols; base += (size_t)t * split_stride; colt -= t * split_cols; if (t == 0) sc = scale0; }
        const int col0 = colt + wc * 32 + 8 * fq, bcol0 = u.pn * BM + wc * 32 + 8 * fq;
        f32x4 bv[2][2];
#pragma unroll
        for (int bj = 0; bj < 2; ++bj)
#pragma unroll
            for (int n = 0; n < 2; ++n) bv[bj][n] = bias ? *(const f32x4*)(bias + bcol0 + bj * HALF + 4 * n) : (f32x4){0.f, 0.f, 0.f, 0.f};
#pragma unroll
        for (int ai = 0; ai < 2; ++ai)
#pragma unroll
            for (int m = 0; m < 4; ++m) { bf16_t* rowp = base + (size_t)(row0 + ai * HALF + m * 16) * ldc + col0;
#pragma unroll
                for (int bj = 0; bj < 2; ++bj) { f32x4 v0 = acc[ai][bj][m][0] + bv[bj][0], v1 = acc[ai][bj][m][1] + bv[bj][1];
                    if (ACT == 1) { f32x2 a = gelu_pk((f32x2){v0[0], v0[1]}), b = gelu_pk((f32x2){v0[2], v0[3]}), c = gelu_pk((f32x2){v1[0], v1[1]}), d = gelu_pk((f32x2){v1[2], v1[3]});
                        v0 = (f32x4){a.x, a.y, b.x, b.y}; v1 = (f32x4){c.x, c.y, d.x, d.y}; }
                    v0 = v0 * sc; v1 = v1 * sc; u32x4 w; w.x = cvt_pk_bf16(v0[0], v0[1]); w.y = cvt_pk_bf16(v0[2], v0[3]); w.z = cvt_pk_bf16(v1[0], v1[1]); w.w = cvt_pk_bf16(v1[2], v1[3]);
                    *(u32x4*)(rowp + bj * HALF) = w; } }
    }
};

template <class Epi, class Sched, bool ALIGN_EPI = false, bool SP2 = false>
__device__ __forceinline__ void gemm_phase(PG8_LAS unsigned char* lds, const Gemm g, const Sched& S, const Epi& E) {
    const int tid = threadIdx.x, wid = __builtin_amdgcn_readfirstlane(tid >> 6), lane = tid & 63, wr = wid >> 2, wc = wid & 3, fr = lane & 15, fq = lane >> 4;
    const int K = g.K, nt = K / BK;
    unsigned voffA[2], voffB[2];
#pragma unroll
    for (int i = 0; i < 2; ++i) { int R, C; stage_rc(tid * 16 + i * 8192, R, C); const int Rb = Epi::PERM ? ((R & ~31) + perm32(R & 31)) : R;
        voffA[i] = (unsigned)(R * K + C) * 2u; voffB[i] = (unsigned)(Rb * K + C) * 2u; }
    const size_t kstep = (size_t)(BK * 2);
    const size_t hstep = (size_t)HALF * K * 2;
    const size_t tstep = 2 * hstep;
    const unsigned ldsw = (unsigned)wid * 1024u;
    const int aoff = lds_byte(wr * 64 + fr, fq * 8), boff = lds_byte(wc * 32 + fr, fq * 8);
#define PG8_SA(b, h) (((b) * 2 + (h)) * HTB)
#define PG8_SB(b, h) ((4 + (b) * 2 + (h)) * HTB)
#define PG8_STAGE(bufoff, gbase, voff) do { _Pragma("unroll") for (int _i = 0; _i < 2; ++_i) \
        __builtin_amdgcn_global_load_lds((const unsigned*)((const char*)(gbase) + (voff)[_i]), (PG8_LAS unsigned*)(lds + (bufoff) + ldsw + _i * 8192), 16, 0, 0); } while (0)
#define PG8_LDA(dst, b, h) do { _Pragma("unroll") for (int m = 0; m < 4; ++m) _Pragma("unroll") for (int k = 0; k < 2; ++k) dst[m][k] = *(const PG8_LAS bf16x8*)(lds + PG8_SA(b, h) + aoff + m * 2048 + k * 1024); } while (0)
#define PG8_LDB(dst, b, h) do { _Pragma("unroll") for (int n = 0; n < 2; ++n) _Pragma("unroll") for (int k = 0; k < 2; ++k) dst[n][k] = *(const PG8_LAS bf16x8*)(lds + PG8_SB(b, h) + boff + n * 2048 + k * 1024); } while (0)
#define PG8_MMA(ai, bj, At, Bt) do { __builtin_amdgcn_s_setprio(1); _Pragma("unroll") for (int m = 0; m < 4; ++m) _Pragma("unroll") for (int n = 0; n < 2; ++n) _Pragma("unroll") for (int k = 0; k < 2; ++k) \
        acc[ai][bj][m][n] = __builtin_amdgcn_mfma_f32_16x16x32_bf16(Bt[n][k], At[m][k], acc[ai][bj][m][n], 0, 0, 0); __builtin_amdgcn_s_setprio(0); } while (0)
#define PG8_WAIT_V(n) asm volatile("s_waitcnt vmcnt(" #n ")" ::: "memory")
#define PG8_WAIT_L(n) asm volatile("s_waitcnt lgkmcnt(" #n ")" ::: "memory")
#define PG8_BAR __builtin_amdgcn_s_barrier()
#define PG8_SCHED __builtin_amdgcn_sched_barrier(0)
    Unit cur, nxt; int ui = 0;
    if (!S.next(0, cur)) return;
    f32x4 acc[2][2][4][2];
#pragma unroll
    for (int a = 0; a < 2; ++a)
#pragma unroll
        for (int b = 0; b < 2; ++b)
#pragma unroll
            for (int m = 0; m < 4; ++m)
#pragma unroll
                for (int n = 0; n < 2; ++n) acc[a][b][m][n] = (f32x4){0.f, 0.f, 0.f, 0.f};
    bf16x8 At[4][2], B0[2][2], B1[2][2];
    const char* cA = (const char*)g.A + (size_t)cur.pm * tstep; const char* cB = (const char*)g.Bt + (size_t)cur.pn * tstep;
    S.a_ready(cur);
    if constexpr (SP2) {
        PG8_STAGE(PG8_SB(0, 0), cB, voffB); PG8_STAGE(PG8_SB(0, 1), cB + hstep, voffB); PG8_STAGE(PG8_SA(0, 0), cA, voffA); PG8_STAGE(PG8_SA(0, 1), cA + hstep, voffA);
        if (wr == 1) PG8_BAR;
        PG8_WAIT_V(2); PG8_BAR;
        PG8_STAGE(PG8_SB(1, 0), cB + kstep, voffB); PG8_STAGE(PG8_SA(1, 0), cA + kstep, voffA); PG8_STAGE(PG8_SB(1, 1), cB + hstep + kstep, voffB);
        PG8_WAIT_V(6); PG8_BAR;
    } else {
        PG8_STAGE(PG8_SB(0, 0), cB, voffB); PG8_STAGE(PG8_SA(0, 0), cA, voffA); PG8_STAGE(PG8_SB(0, 1), cB + hstep, voffB); PG8_STAGE(PG8_SA(0, 1), cA + hstep, voffA);
        if (wr == 1) PG8_BAR;
        PG8_WAIT_V(4); PG8_BAR;
        PG8_STAGE(PG8_SB(1, 0), cB + kstep, voffB); PG8_STAGE(PG8_SA(1, 0), cA + kstep, voffA); PG8_STAGE(PG8_SB(1, 1), cB + hstep + kstep, voffB);
        PG8_WAIT_V(6); PG8_BAR;
    }
    for (;;) {
        const bool has_next = S.next(ui + 1, nxt);
        const char* nA = has_next ? (const char*)g.A + (size_t)nxt.pm * tstep : cA; const char* nB = has_next ? (const char*)g.Bt + (size_t)nxt.pn * tstep : cB;
        for (int t = 0; t < nt; t += 2) {
            const bool last = (t == nt - 2);
            const char* a1 = cA + (size_t)(t + 1) * kstep;
            const char* a2 = last ? nA : cA + (size_t)(t + 2) * kstep; const char* b2 = last ? nB : cB + (size_t)(t + 2) * kstep;
            const char* a3 = a2 + kstep; const char* b3 = b2 + kstep;
            if (last && has_next) S.a_ready(nxt);
            if constexpr (SP2) {
            PG8_LDB(B0, 0, 0); PG8_LDB(B1, 0, 1); PG8_SCHED; PG8_LDA(At, 0, 0); PG8_STAGE(PG8_SA(1, 1), a1 + hstep, voffA);
            PG8_WAIT_V(8); PG8_WAIT_L(0); PG8_BAR; PG8_MMA(0, 0, At, B0); PG8_MMA(0, 1, At, B1); PG8_BAR; PG8_SCHED;
            PG8_LDA(At, 0, 1); PG8_STAGE(PG8_SB(0, 0), b2, voffB); PG8_STAGE(PG8_SB(0, 1), b2 + hstep, voffB); PG8_STAGE(PG8_SA(0, 0), a2, voffA);
            PG8_WAIT_V(8); PG8_WAIT_L(0); PG8_BAR; PG8_MMA(1, 0, At, B0); PG8_MMA(1, 1, At, B1); PG8_BAR; PG8_SCHED;
            PG8_LDB(B0, 1, 0); PG8_LDB(B1, 1, 1); PG8_SCHED; PG8_LDA(At, 1, 0); PG8_STAGE(PG8_SA(0, 1), a2 + hstep, voffA);
            PG8_WAIT_V(8); PG8_WAIT_L(0); PG8_BAR; PG8_MMA(0, 0, At, B0); PG8_MMA(0, 1, At, B1); PG8_BAR; PG8_SCHED;
            PG8_LDA(At, 1, 1); PG8_STAGE(PG8_SB(1, 0), b3, voffB); PG8_STAGE(PG8_SB(1, 1), b3 + hstep, voffB); PG8_STAGE(PG8_SA(1, 0), a3, voffA);
            PG8_WAIT_V(8); PG8_WAIT_L(0); PG8_BAR; PG8_MMA(1, 0, At, B0); PG8_MMA(1, 1, At, B1); PG8_BAR; PG8_SCHED;
            } else {
            PG8_LDB(B0, 0, 0); PG8_SCHED; PG8_LDA(At, 0, 0); PG8_STAGE(PG8_SA(1, 1), a1 + hstep, voffA);
            PG8_WAIT_L(8); PG8_BAR; PG8_WAIT_L(0); PG8_MMA(0, 0, At, B0); PG8_BAR; PG8_SCHED;
            PG8_LDB(B1, 0, 1); PG8_STAGE(PG8_SB(0, 0), b2, voffB);
            PG8_BAR; PG8_WAIT_L(0); PG8_MMA(0, 1, At, B1); PG8_BAR;
            PG8_LDA(At, 0, 1); PG8_STAGE(PG8_SA(0, 0), a2, voffA);
            PG8_BAR; PG8_WAIT_L(0); PG8_MMA(1, 0, At, B0); PG8_BAR; PG8_SCHED;
            PG8_STAGE(PG8_SB(0, 1), b2 + hstep, voffB);
            PG8_WAIT_V(6); PG8_BAR; PG8_MMA(1, 1, At, B1); PG8_BAR;
            PG8_LDB(B0, 1, 0); PG8_SCHED; PG8_LDA(At, 1, 0); PG8_STAGE(PG8_SA(0, 1), a2 + hstep, voffA);
            PG8_WAIT_L(8); PG8_BAR; PG8_WAIT_L(0); PG8_MMA(0, 0, At, B0); PG8_BAR; PG8_SCHED;
            PG8_LDB(B1, 1, 1); PG8_STAGE(PG8_SB(1, 0), b3, voffB);
            PG8_BAR; PG8_WAIT_L(0); PG8_MMA(0, 1, At, B1); PG8_BAR;
            PG8_LDA(At, 1, 1); PG8_STAGE(PG8_SA(1, 0), a3, voffA);
            PG8_BAR; PG8_WAIT_L(0); PG8_MMA(1, 0, At, B0); PG8_BAR; PG8_SCHED;
            PG8_STAGE(PG8_SB(1, 1), b3 + hstep, voffB);
            PG8_WAIT_V(6); PG8_BAR; PG8_MMA(1, 1, At, B1); PG8_BAR;
            }
        }
        if constexpr (ALIGN_EPI) { if (wr == 0) PG8_BAR; }
        if constexpr (!Epi::AFTER_DRAIN) { E(acc, cur, wr, wc, fr, fq); S.done(cur); }
        if (!has_next) break;
#pragma unroll
        for (int a = 0; a < 2; ++a)
#pragma unroll
            for (int b = 0; b < 2; ++b)
#pragma unroll
                for (int m = 0; m < 4; ++m)
#pragma unroll
                    for (int n = 0; n < 2; ++n) acc[a][b][m][n] = (f32x4){0.f, 0.f, 0.f, 0.f};
        cur = nxt; cA = nA; cB = nB; ++ui;
        if constexpr (ALIGN_EPI) { if (wr == 1) PG8_BAR; }
    }
    PG8_WAIT_V(0);
    if constexpr (!ALIGN_EPI) { if (wr == 0) PG8_BAR; }
    PG8_BAR;
    if constexpr (Epi::AFTER_DRAIN) { E.fused(acc, cur, wr, wc, fr, fq, lds, wid, lane); S.done(cur); }
#undef PG8_SA
#undef PG8_SB
#undef PG8_STAGE
#undef PG8_LDA
#undef PG8_LDB
#undef PG8_MMA
#undef PG8_WAIT_V
#undef PG8_WAIT_L
#undef PG8_BAR
#undef PG8_SCHED
}
}

#include <hip/hip_cooperative_groups.h>
namespace cg = cooperative_groups;
#define LAS __attribute__((address_space(3)))
typedef unsigned short bf16;
typedef float f32x4 __attribute__((ext_vector_type(4)));
typedef float f32x2v __attribute__((ext_vector_type(2)));
typedef unsigned u32x2 __attribute__((ext_vector_type(2)));
typedef unsigned u32x4 __attribute__((ext_vector_type(4)));
typedef short bf16x8 __attribute__((ext_vector_type(8)));

constexpr int BATCH = 2, SEQ = 8192, M = BATCH * SEQ, D = 1024, NPROJ = 3584, INCOLS = 3592, FF = 4096;
constexpr int NCH = SEQ / 64;
constexpr float EPS = 1e-6f;
constexpr int NTHR = 512, NWAVES = 8;

constexpr size_t MiB = 1u << 20;
constexpr size_t WS_CTL = 0, CTL_BYTES = 1 * MiB;
constexpr size_t WS_WIN = 2 * MiB, WS_WOUT = 10 * MiB, WS_W1 = 12 * MiB, WS_W2 = 20 * MiB, WS_GB = 28 * MiB, WS_SSQ = 29 * MiB;
constexpr size_t WS_XN = 32 * MiB;
constexpr size_t WS_PROJ = 64 * MiB;
constexpr size_t WS_MIX = 176 * MiB;
constexpr size_t WS_OATT = 208 * MiB;
constexpr size_t WS_ODN = 224 * MiB;
constexpr size_t WS_Z = 64 * MiB;
constexpr size_t WS_END = 256 * MiB;

constexpr int LDS_BYTES = 163840;

__device__ __forceinline__ unsigned f2bf(float f) { unsigned u = __builtin_bit_cast(unsigned, f); return (u + 0x7fffu + ((u >> 16) & 1u)) >> 16; }
__device__ __forceinline__ unsigned pk2(float lo, float hi) { return f2bf(lo) | (f2bf(hi) << 16); }
__device__ __forceinline__ float bflo(unsigned w) { return __builtin_bit_cast(float, w << 16); }
__device__ __forceinline__ float bfhi(unsigned w) { return __builtin_bit_cast(float, w & 0xffff0000u); }
__device__ __forceinline__ float bf2f(bf16 b) { return __builtin_bit_cast(float, (unsigned)b << 16); }
__device__ __forceinline__ float wave_sum(float v) {
#pragma unroll
    for (int o = 1; o < 64; o <<= 1) v += __shfl_xor(v, o);
    return v;
}
typedef float f32x2_t __attribute__((ext_vector_type(2))); typedef __bf16 bf16x2_t __attribute__((ext_vector_type(2)));
__device__ __forceinline__ unsigned cvtpk(float lo, float hi) { f32x2_t v = {lo, hi}; bf16x2_t b = __builtin_convertvector(v, bf16x2_t); return __builtin_bit_cast(unsigned, b); }
__device__ __forceinline__ bf16x8 pack8(const f32x4& a, const f32x4& b) { u32x4 p; p.x = cvtpk(a[0], a[1]); p.y = cvtpk(a[2], a[3]); p.z = cvtpk(b[0], b[1]); p.w = cvtpk(b[2], b[3]); return __builtin_bit_cast(bf16x8, p); }
__device__ __forceinline__ unsigned short f2bf_hw(float x) { return (unsigned short)(cvtpk(x, x) & 0xffffu); }
__device__ __forceinline__ float fexp(float x) { return __builtin_amdgcn_exp2f(x * 1.4426950408889634f); }
__device__ __forceinline__ float frcp(float x) { return __builtin_amdgcn_rcpf(x); }
__device__ __forceinline__ float frsq(float x) { return __builtin_amdgcn_rsqf(x); }
__device__ __forceinline__ float silu_f(float y) { return y * frcp(1.0f + fexp(-y)); }

struct Args {
    const float* in[15]; float* out; unsigned char* ws; int ph_lo, ph_hi;
};

namespace pg8 {
struct EpiResid {
    static constexpr bool PERM = false, AFTER_DRAIN = false;
    const float* base; float* out; bf16_t* hb; float* ssq; int ldc;
    __device__ __forceinline__ void operator()(const f32x4 (&acc)[2][2][4][2], const Unit& u, int wr, int wc, int fr, int fq) const {
        typedef unsigned u32x2v __attribute__((ext_vector_type(2)));
        const int col0 = u.pn * BM + wc * 32 + 4 * fq;
#pragma unroll
        for (int ai = 0; ai < 2; ++ai)
#pragma unroll
            for (int mp = 0; mp < 2; ++mp) {
                f32x4 bs[2][2][2];
#pragma unroll
                for (int mm = 0; mm < 2; ++mm) { const size_t off = (size_t)(u.pm * BM + ai * HALF + wr * 64 + (2 * mp + mm) * 16 + fr) * ldc + col0;
#pragma unroll
                    for (int bj = 0; bj < 2; ++bj)
#pragma unroll
                        for (int n = 0; n < 2; ++n) bs[mm][bj][n] = *(const f32x4*)(base + off + bj * HALF + n * 16); }
                asm volatile("" ::: "memory");
#pragma unroll
                for (int mm = 0; mm < 2; ++mm) { const int m = 2 * mp + mm; const int r = u.pm * BM + ai * HALF + wr * 64 + m * 16 + fr; const size_t off = (size_t)r * ldc + col0; float s = 0.f;
#pragma unroll
                    for (int bj = 0; bj < 2; ++bj)
#pragma unroll
                        for (int n = 0; n < 2; ++n) {
                            const f32x4 o = bs[mm][bj][n] + acc[ai][bj][m][n];
                            if (out) *(f32x4*)(out + off + bj * HALF + n * 16) = o;
                            s += (o[0] * o[0] + o[1] * o[1]) + (o[2] * o[2] + o[3] * o[3]);
                            if (hb) { u32x2v w; w.x = cvt_pk_bf16(o[0], o[1]); w.y = cvt_pk_bf16(o[2], o[3]); *(u32x2v*)(hb + off + bj * HALF + n * 16) = w; }
                        }
                    if (ssq) { s += __shfl_xor(s, 16); s += __shfl_xor(s, 32); if (fq == 0) ssq[(size_t)r * 16 + u.pn * 4 + wc] = s; } }
                asm volatile("" ::: "memory");
            }
    }
};
struct EpiRelu2 {
    static constexpr bool PERM = true, AFTER_DRAIN = false;
    bf16_t* O; int ldc; const float* ssq; float inv_ncol, eps;
    __device__ __forceinline__ void operator()(const f32x4 (&acc)[2][2][4][2], const Unit& u, int wr, int wc, int fr, int fq) const {
        const int row0 = u.pm * BM + wr * 64 + fr; const int col0 = u.pn * BM + wc * 32 + 8 * fq;
        float rsv[2][4];
#pragma unroll
        for (int ai = 0; ai < 2; ++ai)
#pragma unroll
            for (int m = 0; m < 4; ++m) {
                const f32x4* sp = (const f32x4*)(ssq + (size_t)(row0 + ai * HALF + m * 16) * 16);
                const f32x4 s0 = sp[0], s1 = sp[1], s2 = sp[2], s3 = sp[3];
                const float tot = ((s0[0] + s0[1]) + (s0[2] + s0[3])) + ((s1[0] + s1[1]) + (s1[2] + s1[3])) + ((s2[0] + s2[1]) + (s2[2] + s2[3])) + ((s3[0] + s3[1]) + (s3[2] + s3[3]));
                rsv[ai][m] = __builtin_amdgcn_rsqf(tot * inv_ncol + eps);
            }
        asm volatile("" ::: "memory");
#pragma unroll
        for (int ai = 0; ai < 2; ++ai)
#pragma unroll
            for (int m = 0; m < 4; ++m) {
                const float rs = rsv[ai][m];
                bf16_t* rowp = O + (size_t)(row0 + ai * HALF + m * 16) * ldc + col0;
#pragma unroll
                for (int bj = 0; bj < 2; ++bj) {
                    f32x4 v0 = acc[ai][bj][m][0] * rs, v1 = acc[ai][bj][m][1] * rs;
#pragma unroll
                    for (int e = 0; e < 4; ++e) { const float a = fmaxf(v0[e], 0.f), b = fmaxf(v1[e], 0.f); v0[e] = a * a; v1[e] = b * b; }
                    u32x4 w; w.x = cvt_pk_bf16(v0[0], v0[1]); w.y = cvt_pk_bf16(v0[2], v0[3]); w.z = cvt_pk_bf16(v1[0], v1[1]); w.w = cvt_pk_bf16(v1[2], v1[3]);
                    *(u32x4*)(rowp + bj * HALF) = w;
                }
            }
    }
};
struct EpiOutBf {
    static constexpr bool PERM = false, AFTER_DRAIN = false;
    const bf16_t* hb; float* out; int ldc;
    __device__ __forceinline__ void operator()(const f32x4 (&acc)[2][2][4][2], const Unit& u, int wr, int wc, int fr, int fq) const {
        typedef unsigned u32x2v __attribute__((ext_vector_type(2)));
        const int col0 = u.pn * BM + wc * 32 + 4 * fq;
#pragma unroll
        for (int ai = 0; ai < 2; ++ai) {
            u32x2v w[4][2][2];
#pragma unroll
            for (int m = 0; m < 4; ++m) { const size_t off = (size_t)(u.pm * BM + ai * HALF + wr * 64 + m * 16 + fr) * ldc + col0;
#pragma unroll
                for (int bj = 0; bj < 2; ++bj)
#pragma unroll
                    for (int n = 0; n < 2; ++n) w[m][bj][n] = *(const u32x2v*)(hb + off + bj * HALF + n * 16); }
            asm volatile("" ::: "memory");
#pragma unroll
            for (int m = 0; m < 4; ++m) { const size_t off = (size_t)(u.pm * BM + ai * HALF + wr * 64 + m * 16 + fr) * ldc + col0;
#pragma unroll
                for (int bj = 0; bj < 2; ++bj)
#pragma unroll
                    for (int n = 0; n < 2; ++n) {
                        const u32x2v ww = w[m][bj][n];
                        f32x4 bs; bs[0] = __builtin_bit_cast(float, ww.x << 16); bs[1] = __builtin_bit_cast(float, ww.x & 0xffff0000u); bs[2] = __builtin_bit_cast(float, ww.y << 16); bs[3] = __builtin_bit_cast(float, ww.y & 0xffff0000u);
                        *(f32x4*)(out + off + bj * HALF + n * 16) = bs + acc[ai][bj][m][n];
                    } }
            asm volatile("" ::: "memory");
        }
    }
};
}

struct Frame {
    LAS unsigned char* lds;
    int tid, lane, wave, G, gw, NGW;
    const float *x, *mix_gain, *w_in, *q_gain, *k_gain, *rel_bias, *att_out_gain, *conv_w, *a_log, *dt_bias, *dn_out_gain, *w_out, *ffn_gain, *w1, *w2;
    float* out;
    bf16 *WIN_T, *WOUT_T, *W1_T, *W2_T, *XN, *H1B, *PROJ, *MIX, *OATT, *Z, *WKI, *UI, *SnI, *QdI, *AttI, *TinvI;
    float *GB, *SSQ, *CD;
};

__device__ __forceinline__ void transpose_item(const float* W, int ldw, int K, int ncols, const float* kgain, bf16* WT, LAS float* scr, int item, int lane) {
    const int nblk = ncols / 32, kb = item / nblk, nb = item % nblk, k0 = 64 * kb, n0 = 32 * nb;
#pragma unroll
    for (int i = 0; i < 32; ++i) { const int kk = 2 * i + (lane >> 5); float w = W[(size_t)(k0 + kk) * ldw + n0 + (lane & 31)]; if (kgain) w *= kgain[k0 + kk]; scr[kk * 33 + (lane & 31)] = w; }
    asm volatile("s_waitcnt lgkmcnt(0)" ::: "memory");
    const int c = lane & 7;
#pragma unroll
    for (int j = 0; j < 4; ++j) { const int n = (lane >> 3) + 8 * j; const LAS float* s = scr + (8 * c) * 33 + n;
        u32x4 o; o.x = cvtpk(s[0 * 33], s[1 * 33]); o.y = cvtpk(s[2 * 33], s[3 * 33]); o.z = cvtpk(s[4 * 33], s[5 * 33]); o.w = cvtpk(s[6 * 33], s[7 * 33]);
        *(u32x4*)(WT + (size_t)(n0 + n) * K + k0 + 8 * c) = o; }
    asm volatile("s_waitcnt lgkmcnt(0)" ::: "memory");
}

__device__ __forceinline__ void weights_rest(Frame& F, int wv, int nwv) {
    LAS float* scr = (LAS float*)(F.lds + F.wave * 8448);
    constexpr int I_O = (D / 64) * (D / 32), I_1 = (D / 64) * (FF / 32), I_2 = (FF / 64) * (D / 32);
    for (int it = wv; it < I_O + I_1 + I_2; it += nwv) {
        int r = it;
        if (r < I_O) { transpose_item(F.w_out, D, D, D, nullptr, F.WOUT_T, scr, r, F.lane); continue; } r -= I_O;
        if (r < I_1) { transpose_item(F.w1, FF, D, FF, F.ffn_gain, F.W1_T, scr, r, F.lane); continue; } r -= I_1;
        transpose_item(F.w2, D, FF, D, nullptr, F.W2_T, scr, r, F.lane);
    }
}

__device__ __forceinline__ void p0_row(Frame& F, int r, const f32x4 (&v)[4], const f32x4 (&gq)[4], const LAS float* w8, float dtb, float ealg, int ccol) {
    const int lane = F.lane;
    float ss = 0.f;
#pragma unroll
    for (int j = 0; j < 4; ++j) ss += (v[j][0] * v[j][0] + v[j][1] * v[j][1]) + (v[j][2] * v[j][2] + v[j][3] * v[j][3]);
    ss = wave_sum(ss);
    const float rstd = frsq(ss * (1.0f / D) + EPS);
    float ds[8];
#pragma unroll
    for (int c = 0; c < 8; ++c) ds[c] = 0.f;
#pragma unroll
    for (int j = 0; j < 4; ++j) {
        const f32x4 u = v[j] * rstd * gq[j];
        u32x2 w; w.x = cvtpk(u[0], u[1]); w.y = cvtpk(u[2], u[3]);
        *(u32x2*)(F.XN + (size_t)r * D + 256 * j + 4 * lane) = w;
#pragma unroll
        for (int e = 0; e < 4; ++e) {
            const int k = 256 * j + 4 * lane + e;
            const f32x4 w0 = *(const LAS f32x4*)(w8 + k * 8), w1 = *(const LAS f32x4*)(w8 + k * 8 + 4);
#pragma unroll
            for (int c = 0; c < 4; ++c) { ds[c] += u[e] * w0[c]; ds[4 + c] += u[e] * w1[c]; }
        }
    }
    const bool b5 = (lane & 32) != 0, b4 = (lane & 16) != 0, b3 = (lane & 8) != 0;
    float e4[4], e2[2];
#pragma unroll
    for (int c = 0; c < 4; ++c) { const float snd = b5 ? ds[c] : ds[4 + c], kp = b5 ? ds[4 + c] : ds[c]; e4[c] = kp + __shfl_xor(snd, 32); }
#pragma unroll
    for (int c = 0; c < 2; ++c) { const float snd = b4 ? e4[c] : e4[2 + c], kp = b4 ? e4[2 + c] : e4[c]; e2[c] = kp + __shfl_xor(snd, 16); }
    float d;
    { const float snd = b3 ? e2[0] : e2[1], kp = b3 ? e2[1] : e2[0]; d = kp + __shfl_xor(snd, 8); }
    d += __shfl_xor(d, 4); d += __shfl_xor(d, 2); d += __shfl_xor(d, 1);
    if ((lane & 7) == 0) {
        float val;
        if (ccol < 4) { const float a = d + dtb; const float sp = fmaxf(a, 0.f) + __builtin_amdgcn_logf(1.0f + fexp(-fabsf(a))) * 0.6931471805599453f; val = -ealg * sp; }
        else val = frcp(1.0f + fexp(-d));
        F.GB[(size_t)r * 8 + ccol] = val;
    }
}

__device__ __forceinline__ void p0_prologue(Frame& F) {
    LAS float* w8 = (LAS float*)(F.lds + 69632);
#pragma unroll
    for (int q = 0; q < 16; ++q) { const int i = F.tid + q * NTHR; w8[i] = F.w_in[(size_t)(i >> 3) * INCOLS + NPROJ + (i & 7)]; }
    __syncthreads();
    const int lane = F.lane;
    f32x4 gq[4];
#pragma unroll
    for (int j = 0; j < 4; ++j) gq[j] = ((const f32x4*)F.mix_gain)[lane + 64 * j];
    const int ccol = ((lane >> 5) & 1) * 4 + ((lane >> 4) & 1) * 2 + ((lane >> 3) & 1);
    const float dtb = F.dt_bias[ccol & 3], ealg = expf(F.a_log[ccol & 3]);
#define P0_LOAD(buf, rr) do { if ((rr) < M) { _Pragma("unroll") for (int j = 0; j < 4; ++j) buf[j] = ((const f32x4*)(F.x + (size_t)(rr) * D) + lane)[64 * j]; } } while (0)
    f32x4 xa[4], xb[4], xc[4];
    P0_LOAD(xa, F.gw); P0_LOAD(xb, F.gw + F.NGW); P0_LOAD(xc, F.gw + 2 * F.NGW);
    for (int r = F.gw; r < M; r += 3 * F.NGW) {
        p0_row(F, r, xa, gq, w8, dtb, ealg, ccol); P0_LOAD(xa, r + 3 * F.NGW);
        if (r + F.NGW < M) { p0_row(F, r + F.NGW, xb, gq, w8, dtb, ealg, ccol); P0_LOAD(xb, r + 4 * F.NGW); }
        if (r + 2 * F.NGW < M) { p0_row(F, r + 2 * F.NGW, xc, gq, w8, dtb, ealg, ccol); P0_LOAD(xc, r + 5 * F.NGW); }
    }
#undef P0_LOAD
    LAS float* scr = (LAS float*)(F.lds + F.wave * 8448);
    constexpr int I_IN = (D / 64) * (NPROJ / 32);
    for (int it = F.gw; it < I_IN; it += F.NGW) transpose_item(F.w_in, INCOLS, D, NPROJ, nullptr, F.WIN_T, scr, it, lane);
    if (F.G != 256) weights_rest(F, F.gw, F.NGW);
}

#define LDSBAR() asm volatile("s_waitcnt lgkmcnt(0)\n\ts_barrier" ::: "memory")
#define MFMA16(a, b, c) __builtin_amdgcn_mfma_f32_16x16x32_bf16((a), (b), (c), 0, 0, 0)

constexpr int PST = 132;
constexpr int AST = 68;
__device__ __forceinline__ bf16x8 ld8cvt(const LAS float* p) { const f32x4 a = *(const LAS f32x4*)p, b = *(const LAS f32x4*)(p + 4); return pack8(a, b); }
__device__ __forceinline__ void dn_prep_unit(Frame& F, int unit, bool first) {
    const int n = unit & 127, bh = unit >> 7, h = bh & 3, b = bh >> 2;
    const int tid = F.tid, lane = F.lane, wave = F.wave;
    const size_t row0 = (size_t)b * SEQ + (size_t)n * 64;
    LAS float* qf = (LAS float*)F.lds;
    LAS float* kf = qf + 64 * PST;
    LAS float* vf = kf + 64 * PST;
    LAS float* Am = vf + 64 * PST;
    LAS float* An = Am + 64 * AST;
    LAS float* dL = An + 64 * AST;
    LAS float* bL = dL + 64;
    LAS bf16* AttL = (LAS bf16*)(bL + 64);
    if (tid < 384) {
        const int rg = tid / 48, cc = tid - rg * 48, mat = cc >> 4, c8 = (cc & 15) * 8, ch = mat * 512 + h * 128 + c8;
        const bf16* src = F.PROJ + (row0 + 8 * rg) * NPROJ + 1536 + ch;
        u32x4 raw[11];
#pragma unroll
        for (int i = 0; i < 11; ++i) {
            if (i < 3 && n == 0 && rg == 0) raw[i] = (u32x4){0u, 0u, 0u, 0u};
            else raw[i] = *(const u32x4*)(src + ((ptrdiff_t)i - 3) * (ptrdiff_t)NPROJ);
        }
        f32x4 wa[4], wb[4];
#pragma unroll
        for (int j = 0; j < 4; ++j) { wa[j] = *(const f32x4*)(F.conv_w + j * 1536 + ch); wb[j] = *(const f32x4*)(F.conv_w + j * 1536 + ch + 4); }
        LAS float* dst = qf + mat * (64 * PST) + (8 * rg) * PST + c8;
        const float qsc = (mat == 0) ? 0.08838834764831845f : 1.0f;
        f32x4 ya[8], yb[8]; float ss[8];
#pragma unroll
        for (int i = 0; i < 8; ++i) {
            ya[i] = (f32x4){0.f, 0.f, 0.f, 0.f}; yb[i] = (f32x4){0.f, 0.f, 0.f, 0.f};
#pragma unroll
            for (int j = 0; j < 4; ++j) {
                const u32x4 w = raw[i + j];
                ya[i] += wa[j] * (f32x4){bflo(w.x), bfhi(w.x), bflo(w.y), bfhi(w.y)};
                yb[i] += wb[j] * (f32x4){bflo(w.z), bfhi(w.z), bflo(w.w), bfhi(w.w)};
            }
#pragma unroll
            for (int e = 0; e < 4; ++e) { ya[i][e] = silu_f(ya[i][e]); yb[i][e] = silu_f(yb[i][e]); }
            ss[i] = (ya[i][0] * ya[i][0] + ya[i][1] * ya[i][1]) + (ya[i][2] * ya[i][2] + ya[i][3] * ya[i][3]) + (yb[i][0] * yb[i][0] + yb[i][1] * yb[i][1]) + (yb[i][2] * yb[i][2] + yb[i][3] * yb[i][3]);
        }
        if (mat < 2) {
#pragma unroll
            for (int o = 1; o < 16; o <<= 1) {
                float t[8];
#pragma unroll
                for (int i = 0; i < 8; ++i) t[i] = __shfl_xor(ss[i], o);
#pragma unroll
                for (int i = 0; i < 8; ++i) ss[i] += t[i];
            }
#pragma unroll
            for (int i = 0; i < 8; ++i) { const float sc = frsq(ss[i] + EPS) * qsc; ya[i] = ya[i] * sc; yb[i] = yb[i] * sc; }
        }
#pragma unroll
        for (int i = 0; i < 8; ++i) { *(LAS f32x4*)(dst + i * PST) = ya[i]; *(LAS f32x4*)(dst + i * PST + 4) = yb[i]; }
    } else if (wave == 7) {
        if (first) {
#pragma unroll 8
            for (int row = 0; row < 64; ++row) Am[row * AST + lane] = (row == lane) ? 1.0f : 0.0f;
        }
    } else if (wave == 6) {
        float v = F.GB[(row0 + lane) * 8 + h];
#pragma unroll
        for (int o = 1; o < 64; o <<= 1) { const float t = __shfl_up(v, o); if (lane >= o) v += t; }
        dL[lane] = v; bL[lane] = F.GB[(row0 + lane) * 8 + 4 + h];
    }
    LDSBAR();
    {
        const int c = lane & 15, g = lane >> 4, mi = wave >> 1, nj0 = 2 * (wave & 1);
        bf16x8 ak[4], aq[4];
#pragma unroll
        for (int kk = 0; kk < 4; ++kk) { ak[kk] = ld8cvt(kf + (16 * mi + c) * PST + 32 * kk + 8 * g); aq[kk] = ld8cvt(qf + (16 * mi + c) * PST + 32 * kk + 8 * g); }
#pragma unroll
        for (int t = 0; t < 2; ++t) {
            const int nj = nj0 + t;
            f32x4 kk4 = {0.f, 0.f, 0.f, 0.f}, qk4 = {0.f, 0.f, 0.f, 0.f};
#pragma unroll
            for (int kk = 0; kk < 4; ++kk) { const bf16x8 bb = ld8cvt(kf + (16 * nj + c) * PST + 32 * kk + 8 * g); kk4 = MFMA16(ak[kk], bb, kk4); qk4 = MFMA16(aq[kk], bb, qk4); }
            const int j = 16 * nj + c; const float dj = dL[j];
#pragma unroll
            for (int e = 0; e < 4; ++e) {
                const int i = 16 * mi + 4 * g + e; const float di = dL[i], bi = bL[i];
                const float ex = fexp(fminf(di - dj, 0.f));
                const float aij = (j < i) ? bi * kk4[e] * ex : 0.f;
                An[i * AST + j] = aij;
                AttL[i * 64 + j] = (bf16)f2bf_hw((j <= i) ? qk4[e] * ex : 0.f);
            }
        }
    }
    LDSBAR();
    {
        LAS float* Ti = Am;
        const float dlast = dL[63];
        if (wave == 0) {
            const int cl = lane & 15, g = lane >> 4;
#pragma unroll
            for (int b4 = 0; b4 < 4; ++b4) {
                const int i0 = 16 * b4;
                if (b4 > 0) {
                    f32x4 acc3[3] = {{0.f, 0.f, 0.f, 0.f}, {0.f, 0.f, 0.f, 0.f}, {0.f, 0.f, 0.f, 0.f}};
#pragma unroll
                    for (int ks = 0; ks < (b4 == 3 ? 2 : 1); ++ks) {
                        const bool valid = (32 * ks + 8 * g) < i0;
                        const LAS float* ap = An + (i0 + cl) * AST + 32 * ks + 8 * g;
                        f32x4 a0 = *(const LAS f32x4*)ap, a1 = *(const LAS f32x4*)(ap + 4);
                        if (!valid) { a0 = (f32x4){0.f, 0.f, 0.f, 0.f}; a1 = a0; }
                        const bf16x8 Ah = pack8(a0, a1);
#pragma unroll
                        for (int ct = 0; ct < 3; ++ct) if (ct < b4) {
                            const LAS float* xp = Ti + (32 * ks + 8 * g) * AST + 16 * ct + cl;
                            f32x4 x0, x1;
#pragma unroll
                            for (int jj = 0; jj < 4; ++jj) { x0[jj] = xp[jj * AST]; x1[jj] = xp[(4 + jj) * AST]; }
                            acc3[ct] = MFMA16(Ah, pack8(x0, x1), acc3[ct]);
                        }
                    }
#pragma unroll
                    for (int ct = 0; ct < 3; ++ct) if (ct < b4) {
                        LAS float* rp = Ti + (i0 + 4 * g) * AST + 16 * ct + cl;
#pragma unroll
                        for (int e = 0; e < 4; ++e) rp[e * AST] -= acc3[ct][e];
                    }
                }
                LAS float* X = Ti + i0 * AST + lane;
                float x[16];
                f32x4 ac[16][4];
#pragma unroll
                for (int r = 0; r < 16; ++r) x[r] = X[r * AST];
#pragma unroll
                for (int r = 1; r < 16; ++r)
#pragma unroll
                    for (int q4 = 0; q4 < (r + 3) / 4; ++q4) ac[r][q4] = *(const LAS f32x4*)(An + (i0 + r) * AST + i0 + 4 * q4);
                __builtin_amdgcn_sched_barrier(0);
#pragma unroll
                for (int r = 1; r < 16; ++r)
#pragma unroll
                    for (int q4 = 0; q4 < (r + 3) / 4; ++q4)
#pragma unroll
                        for (int e = 0; e < 4; ++e) if (4 * q4 + e < r) x[r] -= ac[r][q4][e] * x[4 * q4 + e];
#pragma unroll
                for (int r = 0; r < 16; ++r) X[r * AST] = x[r];
            }
        } else {
            const int t7 = tid - 64;
#pragma unroll 1
            for (int idx = t7; idx < 1024; idx += 448) {
                const int f = idx >> 6, l = idx & 63, r = l & 15, g = l >> 4, m = f >> 2, s = f & 3, tok = 16 * m + r;
                const float e = fexp(dL[tok]); const LAS float* sp = qf + tok * PST + 32 * s + 4 * g;
                const f32x4 lo = *(const LAS f32x4*)sp * e, hi = *(const LAS f32x4*)(sp + 16) * e;
                *(bf16x8*)(F.QdI + (size_t)unit * 8192 + (size_t)idx * 8) = pack8(lo, hi);
            }
#pragma unroll 1
            for (int idx = t7; idx < 1024; idx += 448) {
                const int f = idx >> 6, l = idx & 63, r = l & 15, g = l >> 4, m = f >> 2, s = f & 3, tok = 16 * m + r;
                const float e = -bL[tok] * fexp(dL[tok]); const LAS float* sp = kf + tok * PST + 32 * s + 4 * g;
                const f32x4 lo = *(const LAS f32x4*)sp * e, hi = *(const LAS f32x4*)(sp + 16) * e;
                *(bf16x8*)(F.WKI + (size_t)unit * 16384 + (size_t)idx * 8) = pack8(lo, hi);
            }
#pragma unroll 1
            for (int idx = t7; idx < 1024; idx += 448) {
                const int f = idx >> 6, l = idx & 63, r = l & 15, g = l >> 4, T = f >> 1, s2 = f & 1, dk = 16 * T + r;
                float v[8];
#pragma unroll
                for (int j = 0; j < 8; ++j) { const int tok = 32 * s2 + 16 * (j >> 2) + 4 * g + (j & 3); v[j] = kf[tok * PST + dk] * fexp(dlast - dL[tok]); }
                u32x4 o; o.x = cvtpk(v[0], v[1]); o.y = cvtpk(v[2], v[3]); o.z = cvtpk(v[4], v[5]); o.w = cvtpk(v[6], v[7]);
                *(u32x4*)(F.WKI + (size_t)unit * 16384 + 8192 + (size_t)idx * 8) = o;
            }
#pragma unroll 1
            for (int idx = t7; idx < 1024; idx += 448) {
                const int f = idx >> 6, l = idx & 63, c = l & 15, g = l >> 4, w = f >> 1, s2 = f & 1, dv = 16 * w + c;
                float v[8];
#pragma unroll
                for (int j = 0; j < 8; ++j) { const int tok = 32 * s2 + 16 * (j >> 2) + 4 * g + (j & 3); v[j] = vf[tok * PST + dv] * bL[tok]; }
                u32x4 o; o.x = cvtpk(v[0], v[1]); o.y = cvtpk(v[2], v[3]); o.z = cvtpk(v[4], v[5]); o.w = cvtpk(v[6], v[7]);
                *(u32x4*)(F.UI + (size_t)unit * 8192 + (size_t)idx * 8) = o;
            }
#pragma unroll 1
            for (int idx = t7; idx < 512; idx += 448) {
                const int f = idx >> 6, l = idx & 63, r = l & 15, g = l >> 4, m = f >> 1, s2 = f & 1, tok = 16 * m + r;
                const LAS bf16* sp = AttL + tok * 64 + 32 * s2 + 4 * g;
                const u32x2 lo = *(const LAS u32x2*)sp, hi = *(const LAS u32x2*)(sp + 16);
                u32x4 o; o.x = lo.x; o.y = lo.y; o.z = hi.x; o.w = hi.y;
                *(u32x4*)(F.AttI + (size_t)unit * 4096 + (size_t)idx * 8) = o;
            }
            if (t7 == 0) F.CD[unit] = fexp(dlast);
        }
        LDSBAR();
        {
            const int idx = tid, f = idx >> 6, l = idx & 63, r = l & 15, g = l >> 4, m = f >> 1, s2 = f & 1, tok = 16 * m + r;
            const LAS float* sp = Ti + tok * AST + 32 * s2 + 4 * g;
            const f32x4 lo = *(const LAS f32x4*)sp, hi = *(const LAS f32x4*)(sp + 16);
            *(bf16x8*)(F.TinvI + (size_t)unit * 4096 + (size_t)idx * 8) = pack8(lo, hi);
            { const int j0 = 32 * s2 + 4 * g; LAS float* wp = Ti + tok * AST + j0;
              *(LAS f32x4*)wp = (f32x4){j0 == tok ? 1.f : 0.f, j0 + 1 == tok ? 1.f : 0.f, j0 + 2 == tok ? 1.f : 0.f, j0 + 3 == tok ? 1.f : 0.f};
              *(LAS f32x4*)(wp + 16) = (f32x4){j0 + 16 == tok ? 1.f : 0.f, j0 + 17 == tok ? 1.f : 0.f, j0 + 18 == tok ? 1.f : 0.f, j0 + 19 == tok ? 1.f : 0.f}; }
        }
    }
}

__device__ __forceinline__ void dn_scan(Frame& F, int sblk) {
    constexpr int STG = 38 * 1024;
    const int bh = sblk >> 2, qd = sblk & 3, wave = F.wave, lane = F.lane;
    const bf16* WK = F.WKI + (size_t)bh * 128 * 16384;
    if (wave >= 4) {
        const int lw = wave - 4;
        const bf16* TQ = F.TinvI + (size_t)bh * 128 * 4096;
#define SCAN_ISSUE(nn) do { _Pragma("unroll") for (int q_ = 0; q_ < 10; ++q_) { const int f_ = lw + 4 * q_; if (f_ < 38) { \
            const int tf_ = f_ - 32, gt_ = (tf_ < 3) ? 2 * tf_ : tf_ + 2;                   \
            const bf16* src_ = (f_ < 32) ? (WK + (size_t)(nn) * 16384 + f_ * 512) : (TQ + (size_t)(nn) * 4096 + gt_ * 512); \
            __builtin_amdgcn_global_load_lds((const unsigned*)(src_ + lane * 8), (LAS unsigned*)(F.lds + ((nn) & 3) * STG + f_ * 1024), 16, 0, 0); } } } while (0)
        SCAN_ISSUE(0); SCAN_ISSUE(1); SCAN_ISSUE(2);
        if (lw < 2) asm volatile("s_waitcnt vmcnt(20)" ::: "memory"); else asm volatile("s_waitcnt vmcnt(18)" ::: "memory");
        __builtin_amdgcn_s_barrier();
#pragma unroll 1
        for (int n = 0; n < NCH; ++n) {
            if (n + 3 < NCH) { SCAN_ISSUE(n + 3); if (lw < 2) asm volatile("s_waitcnt vmcnt(20)" ::: "memory"); else asm volatile("s_waitcnt vmcnt(18)" ::: "memory"); }
            else asm volatile("s_waitcnt vmcnt(0)" ::: "memory");
            __builtin_amdgcn_s_barrier();
        }
#undef SCAN_ISSUE
    } else if (wave < 2) {
        const int w = 2 * qd + wave;
        bf16* UIb = F.UI + (size_t)bh * 128 * 8192 + w * 1024 + lane * 8;
        bf16* SnIb = F.SnI + (size_t)bh * 128 * 16384 + w * 2048 + lane * 8;
        const float cdv0 = F.CD[bh * 128 + lane], cdv1 = F.CD[bh * 128 + 64 + lane];
        f32x4 Sacc[8];
#pragma unroll
        for (int T = 0; T < 8; ++T) Sacc[T] = (f32x4){0.f, 0.f, 0.f, 0.f};
#define SCAN_LD(B0, B1, nn) do { const int n_ = ((nn) < NCH) ? (nn) : NCH - 1; B0 = *(const u32x4*)(UIb + (size_t)n_ * 8192); B1 = *(const u32x4*)(UIb + (size_t)n_ * 8192 + 512); } while (0)
#define SCAN_STEP(nq, u0, u1) do { const int n = (nq); \
            bf16x8 Sb[4]; \
            _Pragma("unroll") for (int s = 0; s < 4; ++s) { Sb[s] = pack8(Sacc[2 * s], Sacc[2 * s + 1]); *(bf16x8*)(SnIb + (size_t)n * 16384 + s * 512) = Sb[s]; } \
            const float cd = __builtin_bit_cast(float, __builtin_amdgcn_readlane(__builtin_bit_cast(int, (n < 64) ? cdv0 : cdv1), n & 63)); \
            const LAS unsigned char* slot = F.lds + (n & 3) * STG + lane * 16; \
            f32x4 Yacc[4]; \
            Yacc[0] = (f32x4){bflo(u0.x), bfhi(u0.x), bflo(u0.y), bfhi(u0.y)}; Yacc[1] = (f32x4){bflo(u0.z), bfhi(u0.z), bflo(u0.w), bfhi(u0.w)}; \
            Yacc[2] = (f32x4){bflo(u1.x), bfhi(u1.x), bflo(u1.y), bfhi(u1.y)}; Yacc[3] = (f32x4){bflo(u1.z), bfhi(u1.z), bflo(u1.w), bfhi(u1.w)}; \
            _Pragma("unroll") for (int s = 0; s < 4; ++s) \
                _Pragma("unroll") for (int m = 0; m < 4; ++m) { const bf16x8 a = *(const LAS bf16x8*)(slot + (m * 4 + s) * 1024); Yacc[m] = MFMA16(a, Sb[s], Yacc[m]); } \
            bf16x8 Yb[2]; \
            _Pragma("unroll") for (int s2 = 0; s2 < 2; ++s2) Yb[s2] = pack8(Yacc[2 * s2], Yacc[2 * s2 + 1]); \
            f32x4 Vacc[4]; const f32x4 zero4 = {0.f, 0.f, 0.f, 0.f}; \
            Vacc[0] = MFMA16(*(const LAS bf16x8*)(slot + 32 * 1024), Yb[0], zero4); \
            Vacc[1] = MFMA16(*(const LAS bf16x8*)(slot + 33 * 1024), Yb[0], zero4); \
            Vacc[2] = MFMA16(*(const LAS bf16x8*)(slot + 34 * 1024), Yb[0], zero4); Vacc[2] = MFMA16(*(const LAS bf16x8*)(slot + 35 * 1024), Yb[1], Vacc[2]); \
            Vacc[3] = MFMA16(*(const LAS bf16x8*)(slot + 36 * 1024), Yb[0], zero4); Vacc[3] = MFMA16(*(const LAS bf16x8*)(slot + 37 * 1024), Yb[1], Vacc[3]); \
            bf16x8 Vb[2]; \
            _Pragma("unroll") for (int s2 = 0; s2 < 2; ++s2) { Vb[s2] = pack8(Vacc[2 * s2], Vacc[2 * s2 + 1]); *(bf16x8*)(UIb + (size_t)n * 8192 + s2 * 512) = Vb[s2]; } \
            _Pragma("unroll") for (int T = 0; T < 8; ++T) Sacc[T] = Sacc[T] * cd; \
            _Pragma("unroll") for (int s2 = 0; s2 < 2; ++s2) \
                _Pragma("unroll") for (int T = 0; T < 8; ++T) { const bf16x8 a = *(const LAS bf16x8*)(slot + (16 + T * 2 + s2) * 1024); Sacc[T] = MFMA16(a, Vb[s2], Sacc[T]); } \
            asm volatile("s_waitcnt lgkmcnt(0)" ::: "memory"); \
            __builtin_amdgcn_s_barrier(); asm volatile("" ::: "memory"); } while (0)
        u32x4 ua0, ua1, ub0, ub1, uc0, uc1;
        SCAN_LD(ua0, ua1, 0); SCAN_LD(ub0, ub1, 1); SCAN_LD(uc0, uc1, 2);
        __builtin_amdgcn_s_barrier();
        asm volatile("" ::: "memory");
#pragma unroll 1
        for (int n3 = 0; n3 < NCH - 2; n3 += 3) {
            SCAN_STEP(n3, ua0, ua1); SCAN_LD(ua0, ua1, n3 + 3);
            SCAN_STEP(n3 + 1, ub0, ub1); SCAN_LD(ub0, ub1, n3 + 4);
            SCAN_STEP(n3 + 2, uc0, uc1); SCAN_LD(uc0, uc1, n3 + 5);
        }
        SCAN_STEP(NCH - 2, ua0, ua1);
        SCAN_STEP(NCH - 1, ub0, ub1);
#undef SCAN_STEP
#undef SCAN_LD
    } else {
        __builtin_amdgcn_s_barrier();
#pragma unroll 1
        for (int n = 0; n < NCH; ++n) __builtin_amdgcn_s_barrier();
    }
    asm volatile("s_waitcnt vmcnt(0) lgkmcnt(0)" ::: "memory");
    __syncthreads();
}

__device__ __forceinline__ void dn_out_task(Frame& F, int task) {
    const int unit = task >> 2, m = task & 3, n = unit & 127, bh = unit >> 7, h = bh & 3, b = bh >> 2, lane = F.lane, c = lane & 15, g = lane >> 4;
    const size_t row0 = (size_t)b * SEQ + (size_t)n * 64 + 16 * m + 4 * g;
    const bf16* Qd = F.QdI + (size_t)unit * 8192 + (size_t)(m * 4) * 512 + lane * 8; const bf16* At = F.AttI + (size_t)unit * 4096 + (size_t)(m * 2) * 512 + lane * 8;
    const bf16* Sn = F.SnI + (size_t)unit * 16384 + lane * 8; const bf16* Vn = F.UI + (size_t)unit * 8192 + lane * 8;
    bf16x8 aq[4], aa[2], bc[6], bn[6];
#pragma unroll
    for (int s = 0; s < 4; ++s) aq[s] = *(const bf16x8*)(Qd + s * 512);
#pragma unroll
    for (int s2 = 0; s2 < 2; ++s2) aa[s2] = *(const bf16x8*)(At + s2 * 512);
#pragma unroll
    for (int s = 0; s < 4; ++s) bc[s] = *(const bf16x8*)(Sn + s * 512);
#pragma unroll
    for (int s2 = 0; s2 < 2; ++s2) bc[4 + s2] = *(const bf16x8*)(Vn + s2 * 512);
    const bf16* gp = F.PROJ + row0 * NPROJ + 3072 + h * 128 + c;
    bf16 graw[4][8];
#pragma unroll
    for (int i = 0; i < 4; ++i)
#pragma unroll
        for (int w = 0; w < 8; ++w) graw[i][w] = gp[(size_t)i * NPROJ + 16 * w];
    float gnv[8];
#pragma unroll
    for (int w = 0; w < 8; ++w) gnv[w] = F.dn_out_gain[16 * w + c];
    __builtin_amdgcn_sched_barrier(0);
    f32x4 O[8]; float ssq[4] = {0.f, 0.f, 0.f, 0.f};
#pragma unroll
    for (int w = 0; w < 8; ++w) {
        if (w < 7) {
#pragma unroll
            for (int s = 0; s < 4; ++s) bn[s] = *(const bf16x8*)(Sn + (w + 1) * 2048 + s * 512);
#pragma unroll
            for (int s2 = 0; s2 < 2; ++s2) bn[4 + s2] = *(const bf16x8*)(Vn + (w + 1) * 1024 + s2 * 512);
        }
        __builtin_amdgcn_sched_barrier(0);
        f32x4 acc = {0.f, 0.f, 0.f, 0.f};
#pragma unroll
        for (int s = 0; s < 4; ++s) acc = MFMA16(aq[s], bc[s], acc);
#pragma unroll
        for (int s2 = 0; s2 < 2; ++s2) acc = MFMA16(aa[s2], bc[4 + s2], acc);
        O[w] = acc;
#pragma unroll
        for (int i = 0; i < 4; ++i) ssq[i] += acc[i] * acc[i];
#pragma unroll
        for (int q = 0; q < 6; ++q) bc[q] = bn[q];
        __builtin_amdgcn_sched_barrier(0);
    }
    float rs[4];
#pragma unroll
    for (int i = 0; i < 4; ++i) { float sq = ssq[i]; sq += __shfl_xor(sq, 1); sq += __shfl_xor(sq, 2); sq += __shfl_xor(sq, 4); sq += __shfl_xor(sq, 8); rs[i] = frsq(sq * (1.0f / 128) + EPS); }
    bf16* mp = F.MIX + row0 * D + 512 + h * 128 + c;
#pragma unroll
    for (int w = 0; w < 8; ++w)
#pragma unroll
        for (int i = 0; i < 4; ++i) mp[(size_t)i * D + 16 * w] = (bf16)f2bf_hw(O[w][i] * rs[i] * gnv[w] * silu_f(bf2f(graw[i][w])));
}

__device__ __forceinline__ void finalize_att_rows(Frame& F) {
    const int lane = F.lane;
    const f32x4 g0 = *(const f32x4*)(F.att_out_gain + 8 * lane), g1 = *(const f32x4*)(F.att_out_gain + 8 * lane + 4);
    for (int r0 = F.gw; r0 < M; r0 += 4 * F.NGW) {
        u32x4 w[4];
#pragma unroll
        for (int q = 0; q < 4; ++q) { const int r = r0 + q * F.NGW; w[q] = (r < M) ? *(const u32x4*)(F.OATT + (size_t)r * 512 + 8 * lane) : (u32x4){0u, 0u, 0u, 0u}; }
#pragma unroll
        for (int q = 0; q < 4; ++q) {
            const int r = r0 + q * F.NGW;
            float v[8];
#pragma unroll
            for (int e = 0; e < 4; ++e) { v[2 * e] = bflo(w[q][e]); v[2 * e + 1] = bfhi(w[q][e]); }
            float ss = 0.f;
#pragma unroll
            for (int e = 0; e < 8; ++e) ss += v[e] * v[e];
            ss = wave_sum(ss);
            const float rs = frsq(ss * (1.0f / 512) + EPS);
            u32x4 o; o.x = cvtpk(v[0] * rs * g0[0], v[1] * rs * g0[1]); o.y = cvtpk(v[2] * rs * g0[2], v[3] * rs * g0[3]); o.z = cvtpk(v[4] * rs * g1[0], v[5] * rs * g1[1]); o.w = cvtpk(v[6] * rs * g1[2], v[7] * rs * g1[3]);
            if (r < M) *(u32x4*)(F.MIX + (size_t)r * D + 8 * lane) = o;
        }
    }
}

typedef short v4i16_t __attribute__((ext_vector_type(4)));
constexpr float LOG2E = 1.4426950408889634f;
constexpr int ATT_K = 0, ATT_V = 73728, ATT_BIAS = 147456;
__device__ __forceinline__ v4i16_t vtr(const LAS unsigned char* p) { return __builtin_amdgcn_ds_read_tr16_b64_v4i16((LAS v4i16_t*)p); }
__device__ __forceinline__ void attn_store_kv(LAS unsigned char* Ks, LAS unsigned char* Vs, int key, int ch, const u32x4& kw, const u32x4& vw, const f32x4& kg0, const f32x4& kg1) {
    float kv[8];
#pragma unroll
    for (int e = 0; e < 4; ++e) { kv[2 * e] = bflo(kw[e]); kv[2 * e + 1] = bfhi(kw[e]); }
    float ss = 0.f;
#pragma unroll
    for (int e = 0; e < 8; ++e) ss += kv[e] * kv[e];
    ss += __shfl_xor(ss, 1); ss += __shfl_xor(ss, 2); ss += __shfl_xor(ss, 4);
    const float rk = frsq(ss * (1.0f / 64) + EPS);
    u32x4 o; o.x = cvtpk(kv[0] * rk * kg0[0], kv[1] * rk * kg0[1]); o.y = cvtpk(kv[2] * rk * kg0[2], kv[3] * rk * kg0[3]); o.z = cvtpk(kv[4] * rk * kg1[0], kv[5] * rk * kg1[1]); o.w = cvtpk(kv[6] * rk * kg1[2], kv[7] * rk * kg1[3]);
    *(LAS u32x4*)(Ks + key * 128 + ((ch ^ (key & 7)) << 4)) = o;
    *(LAS u32x4*)(Vs + key * 128 + ((((ch >> 1) ^ ((key >> 1) & 3)) << 5) + ((ch & 1) << 4))) = vw;
}
constexpr int ATT_ML = ATT_BIAS + 4 * 324 * 4;
constexpr int ATT_SCR = ATT_ML + 2048;
__device__ __forceinline__ void attn_run(Frame& F, int u0, int cnt) {
    const int tid = F.tid, lane = F.lane, wave = F.wave, cl = lane & 15, g = lane >> 4, qt = wave & 3, kh = wave >> 2;
    LAS unsigned char* Ks = F.lds + ATT_K; LAS unsigned char* Vs = F.lds + ATT_V; LAS float* biasR = (LAS float*)(F.lds + ATT_BIAS); LAS float* mlL = (LAS float*)(F.lds + ATT_ML);
    const int ch = tid & 7, kl = tid >> 3;
    const f32x4 kg0 = *(const f32x4*)(F.k_gain + 8 * ch), kg1 = *(const f32x4*)(F.k_gain + 8 * ch + 4);
    const f32x4 ga = *(const f32x4*)(F.q_gain + 8 * g), gb = *(const f32x4*)(F.q_gain + 8 * g + 4), gc2 = *(const f32x4*)(F.q_gain + 32 + 8 * g), gd = *(const f32x4*)(F.q_gain + 32 + 8 * g + 4);
    int cur_bh = -1;
    u32x4 qn0 = {0u, 0u, 0u, 0u}, qn1 = {0u, 0u, 0u, 0u};
#pragma unroll 1
    for (int k = 0; k < cnt; ++k) {
        const int u = u0 + k, bh = u >> 7, c = u & (NCH - 1), b = bh >> 3, h = bh & 7;
        const size_t row0 = (size_t)b * SEQ + (size_t)c * 64;
        if (bh != cur_bh) {
            cur_bh = bh;
            float mq = 0.f, mk = 0.f, bmax = -1e30f;
#pragma unroll 8
            for (int d = 0; d < 64; ++d) { mq = fmaxf(mq, fabsf(F.q_gain[d])); mk = fmaxf(mk, fabsf(F.k_gain[d])); }
            for (int i = tid; i < 320; i += NTHR) bmax = fmaxf(bmax, F.rel_bias[h * 513 + 193 + i]);
#pragma unroll
            for (int o = 1; o < 64; o <<= 1) bmax = fmaxf(bmax, __shfl_xor(bmax, o));
            if (lane == 0) mlL[wave] = bmax;
            LDSBAR();
#pragma unroll
            for (int w8 = 0; w8 < 8; ++w8) bmax = fmaxf(bmax, mlL[w8]);
            const float M2 = (8.0f * mq * mk + bmax) * LOG2E;
            for (int i = tid; i < 4 * 324; i += NTHR) { const int sidx = i / 324, y = i - sidx * 324; int x = 516 - y + sidx; x = x > 512 ? 512 : x; biasR[i] = F.rel_bias[h * 513 + x] * LOG2E - M2; }
#pragma unroll 9
            for (int j = 0; j < 9; ++j) {
                const int gc = c - 8 + j, key = ((gc + 9) % 9) * 64 + kl;
                u32x4 kw = {0u, 0u, 0u, 0u}, vw = {0u, 0u, 0u, 0u};
                if (gc >= 0) { const bf16* kp = F.PROJ + ((size_t)b * SEQ + (size_t)gc * 64 + kl) * NPROJ + 512 + h * 64 + 8 * ch; kw = *(const u32x4*)kp; vw = *(const u32x4*)(kp + 512); }
                attn_store_kv(Ks, Vs, key, ch, kw, vw, kg0, kg1);
            }
            { const bf16* qp = F.PROJ + (row0 + 16 * qt + cl) * NPROJ + h * 64 + 8 * g; qn0 = *(const u32x4*)qp; qn1 = *(const u32x4*)(qp + 32); }
            LDSBAR();
        }
        const bool has_next = (k + 1 < cnt) && (((u + 1) >> 7) == bh);
        u32x4 nk0 = {0u, 0u, 0u, 0u}, nv0 = nk0;
        const u32x4 q0 = qn0, q1 = qn1;
        if (has_next) {
            const bf16* kp = F.PROJ + ((size_t)b * SEQ + (size_t)(c + 1) * 64 + kl) * NPROJ + 512 + h * 64 + 8 * ch;
            nk0 = *(const u32x4*)kp; nv0 = *(const u32x4*)(kp + 512);
            const bf16* qp = F.PROJ + (row0 + 64 + 16 * qt + cl) * NPROJ + h * 64 + 8 * g; qn0 = *(const u32x4*)qp; qn1 = *(const u32x4*)(qp + 32);
        }
        bf16x8 Bq0, Bq1;
        {
            float qv[16];
#pragma unroll
            for (int e = 0; e < 4; ++e) { qv[2 * e] = bflo(q0[e]); qv[2 * e + 1] = bfhi(q0[e]); qv[8 + 2 * e] = bflo(q1[e]); qv[8 + 2 * e + 1] = bfhi(q1[e]); }
            float ss = 0.f;
#pragma unroll
            for (int e = 0; e < 16; ++e) ss += qv[e] * qv[e];
            ss += __shfl_xor(ss, 16); ss += __shfl_xor(ss, 32);
            const float rq = frsq(ss * (1.0f / 64) + EPS) * (0.125f * LOG2E);
            u32x4 p0, p1;
            p0.x = cvtpk(qv[0] * rq * ga[0], qv[1] * rq * ga[1]); p0.y = cvtpk(qv[2] * rq * ga[2], qv[3] * rq * ga[3]); p0.z = cvtpk(qv[4] * rq * gb[0], qv[5] * rq * gb[1]); p0.w = cvtpk(qv[6] * rq * gb[2], qv[7] * rq * gb[3]);
            p1.x = cvtpk(qv[8] * rq * gc2[0], qv[9] * rq * gc2[1]); p1.y = cvtpk(qv[10] * rq * gc2[2], qv[11] * rq * gc2[3]); p1.z = cvtpk(qv[12] * rq * gd[0], qv[13] * rq * gd[1]); p1.w = cvtpk(qv[14] * rq * gd[2], qv[15] * rq * gd[3]);
            Bq0 = __builtin_bit_cast(bf16x8, p0); Bq1 = __builtin_bit_cast(bf16x8, p1);
        }
        const int s0 = (c + 1) % 9, T0 = 18 * kh;
        const int off0 = (g ^ (cl & 7)) << 4, off1 = ((4 + g) ^ (cl & 7)) << 4;
        const int qi = 16 * qt + cl, sb3 = cl & 3;
        const LAS float* Rs = biasR + sb3 * 324;
        const int base0 = 768 + qi - 4 * g - sb3 - 16 * T0;
        f32x4 st[18];
#pragma unroll
        for (int t = 0; t < 18; ++t) {
            const int T = T0 + t, j = T >> 2; int sl = s0 + j; sl = sl >= 9 ? sl - 9 : sl;
            const LAS unsigned char* kb = Ks + (sl * 64 + (T & 3) * 16 + cl) * 128;
            const bf16x8 a0 = *(const LAS bf16x8*)(kb + off0), a1 = *(const LAS bf16x8*)(kb + off1);
            int b4 = base0 - 16 * t; b4 = b4 > 516 ? 516 : b4;
            f32x4 z = *(const LAS f32x4*)(Rs + (516 - b4));
            z = MFMA16(a0, Bq0, z); st[t] = MFMA16(a1, Bq1, z);
        }
        if (c < 8) {
#pragma unroll
            for (int t = 0; t < 18; ++t) if (c - 8 + ((T0 + t) >> 2) < 0) st[t] = (f32x4){-1e30f, -1e30f, -1e30f, -1e30f};
        }
        float lsum = 0.f;
#pragma unroll
        for (int t = 0; t < 18; ++t)
#pragma unroll
            for (int i = 0; i < 4; ++i) { const float p = __builtin_amdgcn_exp2f(st[t][i]); st[t][i] = p; lsum += p; }
        lsum += __shfl_xor(lsum, 16); lsum += __shfl_xor(lsum, 32);
        f32x4 o[4];
#pragma unroll
        for (int dt = 0; dt < 4; ++dt) o[dt] = (f32x4){0.f, 0.f, 0.f, 0.f};
        {
            const int q4 = cl >> 2, p4 = cl & 3, sw = (2 * g + (q4 >> 1)) & 3;
#pragma unroll
            for (int ks = 0; ks < 9; ++ks) {
                const int T = T0 + 2 * ks, j = T >> 2; int sl = s0 + j; sl = sl >= 9 ? sl - 9 : sl;
                const LAS unsigned char* vb = Vs + (sl * 64 + (T & 3) * 16 + 4 * g + q4) * 128 + 8 * p4;
                const bf16x8 pb = pack8(st[2 * ks], st[2 * ks + 1]);
#pragma unroll
                for (int dt = 0; dt < 4; ++dt) {
                    const v4i16_t lo = vtr(vb + ((dt ^ sw) << 5)), hi = vtr(vb + 2048 + ((dt ^ sw) << 5));
                    const bf16x8 a = __builtin_shufflevector(lo, hi, 0, 1, 2, 3, 4, 5, 6, 7);
                    o[dt] = MFMA16(a, pb, o[dt]);
                }
            }
        }
        LAS unsigned* scr = (LAS unsigned*)(F.lds + ATT_SCR);
        if (kh == 1) {
#pragma unroll
            for (int dt = 0; dt < 4; ++dt) { scr[(qt * 8 + 2 * dt) * 64 + lane] = cvtpk(o[dt][0], o[dt][1]); scr[(qt * 8 + 2 * dt + 1) * 64 + lane] = cvtpk(o[dt][2], o[dt][3]); }
            mlL[256 + qt * 64 + lane] = lsum;
        }
        LDSBAR();
        if (kh == 0) {
            const float l1 = mlL[256 + qt * 64 + lane];
            const float inv = frcp(lsum + l1);
            bf16* op = F.OATT + (row0 + qi) * 512 + h * 64 + 4 * g;
#pragma unroll
            for (int dt = 0; dt < 4; ++dt) {
                const unsigned w0 = scr[(qt * 8 + 2 * dt) * 64 + lane], w1 = scr[(qt * 8 + 2 * dt + 1) * 64 + lane];
                u32x2 w; w.x = cvtpk((o[dt][0] + bflo(w0)) * inv, (o[dt][1] + bfhi(w0)) * inv); w.y = cvtpk((o[dt][2] + bflo(w1)) * inv, (o[dt][3] + bfhi(w1)) * inv);
                *(u32x2*)(op + 16 * dt) = w;
            }
        }
        if (has_next) attn_store_kv(Ks, Vs, s0 * 64 + kl, ch, nk0, nv0, kg0, kg1);
        LDSBAR();
    }
}
__device__ __forceinline__ void attn_static(Frame& F, int ab, int nab) {
    const int total = BATCH * 8 * NCH;
    int start, cnt;
    if (nab == 224) {
        const int bh = ab / 14, r = ab - bh * 14;
        start = bh * NCH + r * 9 + (r < 2 ? r : 2); cnt = 9 + (r < 2 ? 1 : 0);
    } else {
        const int base = total / nab, rem = total % nab;
        start = ab * base + (ab < rem ? ab : rem); cnt = base + (ab < rem ? 1 : 0);
    }
    attn_run(F, start, cnt);
}

#define RLX_AGENT __ATOMIC_RELAXED, __HIP_MEMORY_SCOPE_AGENT
#define XB_TMO      128
#define XB_XCNT(j)  (256  + 64 * (j))
#define XB_XSUB(j)  (1280 + 64 * (j))
#define XB_XGEN(j)  (2304 + 64 * (j))
#define XB_TOP      3328
#define XB_TOPGEN   3392
#define XCD_BAR_WORDS 3456
#define XB_SPIN_CAP (1u << 18)

__device__ __forceinline__ unsigned xb_ld(unsigned* p)              { return __hip_atomic_load(p, __ATOMIC_RELAXED, __HIP_MEMORY_SCOPE_AGENT); }
__device__ __forceinline__ unsigned xb_add(unsigned* p, unsigned v) { return __hip_atomic_fetch_add(p, v, __ATOMIC_RELAXED, __HIP_MEMORY_SCOPE_AGENT); }
__device__ __forceinline__ unsigned xb_xcc_id() { return (unsigned)__builtin_amdgcn_s_getreg((3 << 11) | 20) & 0xFu; }
#define XB_SPIN(cond, bar) do { unsigned _sp = 0; while (cond) { __builtin_amdgcn_s_sleep(1); \
    if ((++_sp & 255u) == 0u) { if (xb_ld(&(bar)[XB_TMO])) break; if (_sp > XB_SPIN_CAP) { atomicAdd(&(bar)[XB_TMO], 1u); break; } } } } while (0)

struct XcdBarrier {
    unsigned* bar; unsigned x;
    volatile LAS unsigned* st;
};

__device__ __forceinline__ XcdBarrier xcd_barrier_post(unsigned* bar, volatile LAS unsigned* st) {
    XcdBarrier b; b.bar = bar; b.x = xb_xcc_id(); b.st = st;
    if (threadIdx.x == 0) (void)xb_add(&bar[XB_XCNT(b.x)], 1u);
    return b;
}
__device__ __forceinline__ void xcd_barrier_complete(unsigned* bar, unsigned x, unsigned& nloc, unsigned& nx) {
    const unsigned G = gridDim.x * gridDim.y * gridDim.z;
    unsigned sum, cnt, mine, sp = 0u;
    for (;;) {
        sum = 0u; cnt = 0u; mine = 0u;
#pragma unroll
        for (unsigned j = 0; j < 16; ++j) { const unsigned c = xb_ld(&bar[XB_XCNT(j)]); sum += c; cnt += (c > 0u) ? 1u : 0u; mine = (j == x) ? c : mine; }
        if (sum == G) break;
        __builtin_amdgcn_s_sleep(1);
        if ((++sp & 255u) == 0u) { if (xb_ld(&bar[XB_TMO])) break; if (sp > XB_SPIN_CAP) { atomicAdd(&bar[XB_TMO], 1u); break; } }
    }
    nloc = mine > 0u ? mine : 1u; nx = cnt > 0u ? cnt : 1u;
}

__device__ __forceinline__ void xcd_barrier(const XcdBarrier& b) {
    asm volatile("s_waitcnt vmcnt(0)" ::: "memory");
    __syncthreads();
    if (threadIdx.x == 0) {
        unsigned* bar = b.bar;
        __builtin_amdgcn_s_waitcnt(0);
        unsigned nloc = b.st[0], nx = b.st[1];
        if (nloc == 0u) { xcd_barrier_complete(bar, b.x, nloc, nx); b.st[0] = nloc; b.st[1] = nx; }
        const unsigned old = xb_add(&bar[XB_XSUB(b.x)], 1u);
        const unsigned gen = old / nloc;
        if (old + 1u == (gen + 1u) * nloc) {
            __builtin_amdgcn_fence(__ATOMIC_RELEASE, "agent");
            asm volatile("s_waitcnt vmcnt(0)" ::: "memory");
            const unsigned og = xb_add(&bar[XB_TOP], 1u);
            const unsigned tg = og / nx;
            if (og + 1u == (tg + 1u) * nx) xb_add(&bar[XB_TOPGEN], 1u);
            else XB_SPIN(xb_ld(&bar[XB_TOPGEN]) == tg, bar);
            __builtin_amdgcn_fence(__ATOMIC_ACQUIRE, "agent");
            xb_add(&bar[XB_XGEN(b.x)], 1u);
            asm volatile("s_waitcnt vmcnt(0)" ::: "memory");
        } else {
            XB_SPIN(xb_ld(&bar[XB_XGEN(b.x)]) == gen, bar);
            __builtin_amdgcn_fence(__ATOMIC_ACQUIRE, "agent");
            asm volatile("s_waitcnt vmcnt(0)" ::: "memory");
        }
    }
    __syncthreads();
}

#ifndef PROBE_DUP
#define PROBE_DUP -1
#endif
constexpr int N_PHASES = 8;
__global__ void __launch_bounds__(NTHR, 2) hymba_fwd(Args args) {
    extern __shared__ __attribute__((aligned(16))) unsigned char lds[];
    Frame F;
    F.lds = (LAS unsigned char*)lds;
    F.tid = threadIdx.x; F.lane = F.tid & 63; F.wave = __builtin_amdgcn_readfirstlane(F.tid >> 6);
    F.G = gridDim.x; F.gw = blockIdx.x * NWAVES + F.wave; F.NGW = F.G * NWAVES;
    F.x = args.in[0]; F.mix_gain = args.in[1]; F.w_in = args.in[2]; F.q_gain = args.in[3]; F.k_gain = args.in[4]; F.rel_bias = args.in[5]; F.att_out_gain = args.in[6];
    F.conv_w = args.in[7]; F.a_log = args.in[8]; F.dt_bias = args.in[9]; F.dn_out_gain = args.in[10]; F.w_out = args.in[11]; F.ffn_gain = args.in[12]; F.w1 = args.in[13]; F.w2 = args.in[14];
    F.out = args.out;
    unsigned char* ws = args.ws;
    F.WIN_T = (bf16*)(ws + WS_WIN); F.WOUT_T = (bf16*)(ws + WS_WOUT); F.W1_T = (bf16*)(ws + WS_W1); F.W2_T = (bf16*)(ws + WS_W2);
    F.GB = (float*)(ws + WS_GB); F.SSQ = (float*)(ws + WS_SSQ);
    F.XN = (bf16*)(ws + WS_XN); F.H1B = F.XN; F.WKI = F.XN;
    F.PROJ = (bf16*)(ws + WS_PROJ); F.MIX = (bf16*)(ws + WS_MIX); F.OATT = (bf16*)(ws + WS_OATT); F.Z = (bf16*)(ws + WS_Z);
    F.UI = (bf16*)(ws + WS_ODN); F.CD = (float*)(ws + WS_ODN + 16 * MiB); F.TinvI = (bf16*)(ws + WS_ODN + 24 * MiB);
    F.SnI = (bf16*)args.out; F.QdI = F.SnI + (size_t)16 * MiB; F.AttI = F.SnI + (size_t)24 * MiB;
    volatile LAS unsigned* MISC = (volatile LAS unsigned*)(F.lds + LDS_BYTES - 64);
    if (F.tid < 16) MISC[F.tid] = 0u;
    __syncthreads();
    XcdBarrier bar = xcd_barrier_post((unsigned*)(args.ws + WS_CTL) + 1024, MISC + 8);
    const int lo = args.ph_lo, hi = args.ph_hi;
#define IN(k) (lo <= (k) && (k) < hi)
#define SEAM(k) do { if (IN(k) && IN((k) + 1)) xcd_barrier(bar); } while (0)

    if (IN(0)) { p0_prologue(F); if (PROBE_DUP == 0) { xcd_barrier(bar); p0_prologue(F); } }
    SEAM(0);
    if (PROBE_DUP == 9) { xcd_barrier(bar); xcd_barrier(bar); xcd_barrier(bar); xcd_barrier(bar); }
    if (IN(1)) {
        pg8::Gemm g{F.XN, F.WIN_T, M, NPROJ, D}; pg8::StaticOrder S; S.init(M, NPROJ, F.G, (int)blockIdx.x);
        pg8::EpiBf16<0> E{F.PROJ, NPROJ, nullptr, 0, 0, 1.f};
        pg8::gemm_phase<pg8::EpiBf16<0>, pg8::StaticOrder, true, true>(F.lds, g, S, E);
        if (F.G == 256 && blockIdx.x >= 128) weights_rest(F, ((int)blockIdx.x - 128) * NWAVES + F.wave, 128 * NWAVES);
        if (PROBE_DUP == 1) { xcd_barrier(bar); pg8::gemm_phase<pg8::EpiBf16<0>, pg8::StaticOrder, true, true>(F.lds, g, S, E); }
    }
    SEAM(1);
    if (IN(2)) { bool first = true; for (int u = blockIdx.x; u < 1024; u += F.G) { dn_prep_unit(F, u, first); first = false; } }
    SEAM(2);
    if (IN(3)) { if (PROBE_DUP == 8) { attn_static(F, (int)blockIdx.x, F.G); xcd_barrier(bar); if (blockIdx.x < 32) dn_scan(F, (int)blockIdx.x); } else if (blockIdx.x < 32) dn_scan(F, (int)blockIdx.x); else attn_static(F, (int)blockIdx.x - 32, F.G - 32); if (PROBE_DUP == 3) { xcd_barrier(bar); attn_static(F, (int)blockIdx.x, F.G); } }
    SEAM(3);
    if (IN(4)) { for (int t = F.gw; t < 4096; t += F.NGW) dn_out_task(F, t); finalize_att_rows(F); if (PROBE_DUP == 4) { xcd_barrier(bar); for (int t = F.gw; t < 4096; t += F.NGW) dn_out_task(F, t); finalize_att_rows(F); } }
    SEAM(4);
    if (IN(5)) {
        pg8::Gemm g{F.MIX, F.WOUT_T, M, D, D}; pg8::StaticOrder S; S.init(M, D, F.G, (int)blockIdx.x);
        pg8::EpiResid E{F.x, nullptr, F.H1B, F.SSQ, D};
        pg8::gemm_phase<pg8::EpiResid, pg8::StaticOrder, false, true>(F.lds, g, S, E);
        if (PROBE_DUP == 5) { xcd_barrier(bar); pg8::gemm_phase<pg8::EpiResid, pg8::StaticOrder, false, true>(F.lds, g, S, E); }
    }
    SEAM(5);
    if (IN(6)) {
        pg8::Gemm g{F.H1B, F.W1_T, M, FF, D}; pg8::StaticOrder S; S.init(M, FF, F.G, (int)blockIdx.x);
        pg8::EpiRelu2 E{F.Z, FF, F.SSQ, 1.0f / D, EPS};
        pg8::gemm_phase<pg8::EpiRelu2, pg8::StaticOrder, true, true>(F.lds, g, S, E);
        if (PROBE_DUP == 6) { xcd_barrier(bar); pg8::gemm_phase<pg8::EpiRelu2, pg8::StaticOrder, true, true>(F.lds, g, S, E); }
    }
    SEAM(6);
    if (IN(7)) {
        pg8::Gemm g{F.Z, F.W2_T, M, D, FF}; pg8::StaticOrder S; S.init(M, D, F.G, (int)blockIdx.x);
        pg8::EpiOutBf E{F.H1B, F.out, D};
        pg8::gemm_phase<pg8::EpiOutBf, pg8::StaticOrder, false, true>(F.lds, g, S, E);
    }
#undef IN
#undef SEAM
}

#ifndef MK_N_LAUNCHES
#define MK_N_LAUNCHES 1
#endif
extern "C" void kernel_launch(void* const* d_in, const int* in_sizes, int n_in, void* d_out, int out_size, void* d_ws, size_t ws_size, hipStream_t stream) {
    static int grid = 0;
    if (grid == 0) {
        if (n_in != 15 || in_sizes[0] != M * D || out_size != M * D || ws_size < WS_END) { fprintf(stderr, "kernel_launch: unexpected shapes (n_in %d, in0 %d, out %d, ws %zu); nothing launched\n", n_in, n_in > 0 ? in_sizes[0] : -1, out_size, ws_size); grid = -1; return; }
        int dev = 0, cus = 0, per_cu = 0;
        if (hipGetDevice(&dev) != hipSuccess || hipDeviceGetAttribute(&cus, hipDeviceAttributeMultiprocessorCount, dev) != hipSuccess) { grid = -1; return; }
        if (hipFuncSetAttribute((const void*)hymba_fwd, hipFuncAttributeMaxDynamicSharedMemorySize, LDS_BYTES) != hipSuccess) { fprintf(stderr, "kernel_launch: hipFuncSetAttribute failed\n"); grid = -1; return; }
        if (hipOccupancyMaxActiveBlocksPerMultiprocessor(&per_cu, (const void*)hymba_fwd, NTHR, LDS_BYTES) != hipSuccess || per_cu < 1) { fprintf(stderr, "kernel_launch: occupancy query says %d blocks per CU\n", per_cu); (void)hipGetLastError(); per_cu = 1; }
        grid = cus * (per_cu > 1 ? 1 : per_cu);
        if (grid > 256) grid = 256;
    }
    if (grid < 0) return;
    if (hipMemsetAsync((char*)d_ws + WS_CTL, 0, 65536, stream) != hipSuccess) { fprintf(stderr, "kernel_launch: memset failed\n"); return; }
    Args a{};
    for (int i = 0; i < 15; ++i) a.in[i] = (const float*)d_in[i];
    a.out = (float*)d_out; a.ws = (unsigned char*)d_ws;
#if MK_N_LAUNCHES == 1
    a.ph_lo = 0; a.ph_hi = N_PHASES;
    void* kargs[] = {&a};
    hipError_t e = hipLaunchCooperativeKernel((const void*)hymba_fwd, dim3(grid), dim3(NTHR), kargs, LDS_BYTES, stream);
    if (e != hipSuccess) fprintf(stderr, "kernel_launch: cooperative launch failed: %s (grid %d)\n", hipGetErrorString(e), grid);
#else
    for (int p = 0; p < N_PHASES; ++p) { a.ph_lo = p; a.ph_hi = p + 1; hipLaunchKernelGGL(hymba_fwd, dim3(grid), dim3(NTHR), LDS_BYTES, stream, a); }
#endif
}
```

```cpp
#include <hip/hip_runtime.h>
#include <cstdio>
#include <cstdint>
namespace pg8 {
#define PG8_LAS __attribute__((address_space(3)))
typedef unsigned short bf16_t;
typedef short bf16x8 __attribute__((ext_vector_type(8)));
typedef float f32x4 __attribute__((ext_vector_type(4)));
typedef unsigned u32x4 __attribute__((ext_vector_type(4)));
constexpr int BM = 256, BK = 64, HALF = 128, HTB = HALF * BK * 2  , STAGE_BYTES = 8 * HTB, NXCD = 8, WGM = 4;

__host__ __device__ __forceinline__ int lds_byte(int r, int c) { const int st = (r >> 4) * 2 + (c >> 5), rr = r & 15, cc = c & 31, ob = rr * 64 + cc * 2; return st * 1024 + (ob ^ (((ob >> 9) & 1) << 5)); }
__host__ __device__ __forceinline__ void stage_rc(int b, int& R, int& C) { const int st = b / 1024, sb = b % 1024, swz = sb ^ (((sb >> 9) & 1) << 5); R = (st >> 1) * 16 + swz / 64; C = (st & 1) * 32 + (swz % 64) / 2; }
__host__ __device__ __forceinline__ int perm32(int rho) { const int n = rho >> 4, i = rho & 15; return 8 * (i >> 2) + 4 * n + (i & 3); }

struct Unit { int pm, pn; };
struct Gemm { const bf16_t* A; const bf16_t* Bt; int M, N, K; };

struct StaticOrder {
    int nM, nN, nwg, G, c;
    __host__ __device__ void init(int M, int N, int G_, int c_) { nM = M / BM; nN = N / BM; nwg = nM * nN; G = G_; c = c_; }
    __host__ __device__ bool next(int i, Unit& u) const {
        const long L = (long)i * G + c; if (L >= nwg) return false;
        int wgid = (int)L; { const int q = nwg / NXCD, r = nwg % NXCD, xcd = wgid % NXCD, off = wgid / NXCD; wgid = (xcd < r ? xcd * (q + 1) : r * (q + 1) + (xcd - r) * q) + off; }
        const int nig = WGM * nN, gid = wgid / nig, fm = gid * WGM, gsz = (nM - fm) < WGM ? (nM - fm) : WGM;
        u.pm = fm + ((wgid % nig) % gsz); u.pn = (wgid % nig) / gsz; return true;
    }
    __device__ __forceinline__ void a_ready(const Unit&) const {}
    __device__ __forceinline__ void done(const Unit&) const {}
};

__device__ __forceinline__ unsigned cvt_pk_bf16(float lo, float hi) { unsigned r; asm volatile("v_cvt_pk_bf16_f32 %0, %1, %2" : "=v"(r) : "v"(lo), "v"(hi)); return r; }
typedef float f32x2 __attribute__((ext_vector_type(2)));
__device__ __forceinline__ f32x2 gelu_pk(f32x2 v) {
    const f32x2 av = __builtin_elementwise_abs(v), d = av * 0.2316418882f + 1.0f;
    f32x2 t; t.x = __builtin_amdgcn_rcpf(d.x); t.y = __builtin_amdgcn_rcpf(d.y);
    f32x2 q = t * 0.5307027145f + (-0.7265760135f); q = q * t + 0.7107068705f; q = q * t + (-0.142248368f); q = q * t + 0.127414796f; q = q * t;
    const f32x2 s = (v * v) * (-0.72134752044f);
    f32x2 e; e.x = __builtin_amdgcn_exp2f(s.x); e.y = __builtin_amdgcn_exp2f(s.y);
    const f32x2 m = v * (q * e), r = v - m;
    f32x2 o; o.x = v.x < 0.f ? m.x : r.x; o.y = v.y < 0.f ? m.y : r.y; return o;
}

template <int ACT  > struct EpiBf16 {
    static constexpr bool PERM = true, AFTER_DRAIN = false; static_assert(ACT == 0 || ACT == 1, "EpiBf16: ACT is 0 (none) or 1 (gelu_pk)");
    bf16_t* O; int ldc; const float* bias; int split_cols; size_t split_stride; float scale0;
    __device__ __forceinline__ void operator()(const f32x4 (&acc)[2][2][4][2], const Unit& u, int wr, int wc, int fr, int fq) const {
        const int row0 = u.pm * BM + wr * 64 + fr; int colt = u.pn * BM; bf16_t* base = O;
        float sc = 1.f; if (split_cols) { const int t = colt / split_cols; base += (size_t)t * split_stride; colt -= t * split_cols; if (t == 0) sc = scale0; }
        const int col0 = colt + wc * 32 + 8 * fq, bcol0 = u.pn * BM + wc * 32 + 8 * fq;
        f32x4 bv[2][2];
#pragma unroll
        for (int bj = 0; bj < 2; ++bj)
#pragma unroll
            for (int n = 0; n < 2; ++n) bv[bj][n] = bias ? *(const f32x4*)(bias + bcol0 + bj * HALF + 4 * n) : (f32x4){0.f, 0.f, 0.f, 0.f};
#pragma unroll
        for (int ai = 0; ai < 2; ++ai)
#pragma unroll
            for (int m = 0; m < 4; ++m) { bf16_t* rowp = base + (size_t)(row0 + ai * HALF + m * 16) * ldc + col0;
#pragma unroll
                for (int bj = 0; bj < 2; ++bj) { f32x4 v0 = acc[ai][bj][m][0] + bv[bj][0], v1 = acc[ai][bj][m][1] + bv[bj][1];
                    if (ACT == 1) { f32x2 a = gelu_pk((f32x2){v0[0], v0[1]}), b = gelu_pk((f32x2){v0[2], v0[3]}), c = gelu_pk((f32x2){v1[0], v1[1]}), d = gelu_pk((f32x2){v1[2], v1[3]});
                        v0 = (f32x4){a.x, a.y, b.x, b.y}; v1 = (f32x4){c.x, c.y, d.x, d.y}; }
                    v0 = v0 * sc; v1 = v1 * sc; u32x4 w; w.x = cvt_pk_bf16(v0[0], v0[1]); w.y = cvt_pk_bf16(v0[2], v0[3]); w.z = cvt_pk_bf16(v1[0], v1[1]); w.w = cvt_pk_bf16(v1[2], v1[3]);
                    *(u32x4*)(rowp + bj * HALF) = w; } }
    }
};

template <class Epi, class Sched, bool ALIGN_EPI = false, bool SP2 = false>
__device__ __forceinline__ void gemm_phase(PG8_LAS unsigned char* lds, const Gemm g, const Sched& S, const Epi& E) {
    const int tid = threadIdx.x, wid = __builtin_amdgcn_readfirstlane(tid >> 6), lane = tid & 63, wr = wid >> 2, wc = wid & 3, fr = lane & 15, fq = lane >> 4;
    const int K = g.K, nt = K / BK;
    unsigned voffA[2], voffB[2];
#pragma unroll
    for (int i = 0; i < 2; ++i) { int R, C; stage_rc(tid * 16 + i * 8192, R, C); const int Rb = Epi::PERM ? ((R & ~31) + perm32(R & 31)) : R;
        voffA[i] = (unsigned)(R * K + C) * 2u; voffB[i] = (unsigned)(Rb * K + C) * 2u; }
    const size_t kstep = (size_t)(BK * 2);
    const size_t hstep = (size_t)HALF * K * 2;
    const size_t tstep = 2 * hstep;
    const unsigned ldsw = (unsigned)wid * 1024u;
    const int aoff = lds_byte(wr * 64 + fr, fq * 8), boff = lds_byte(wc * 32 + fr, fq * 8);
#define PG8_SA(b, h) (((b) * 2 + (h)) * HTB)
#define PG8_SB(b, h) ((4 + (b) * 2 + (h)) * HTB)
#define PG8_STAGE(bufoff, gbase, voff) do { _Pragma("unroll") for (int _i = 0; _i < 2; ++_i) \
        __builtin_amdgcn_global_load_lds((const unsigned*)((const char*)(gbase) + (voff)[_i]), (PG8_LAS unsigned*)(lds + (bufoff) + ldsw + _i * 8192), 16, 0, 0); } while (0)
#define PG8_LDA(dst, b, h) do { _Pragma("unroll") for (int m = 0; m < 4; ++m) _Pragma("unroll") for (int k = 0; k < 2; ++k) dst[m][k] = *(const PG8_LAS bf16x8*)(lds + PG8_SA(b, h) + aoff + m * 2048 + k * 1024); } while (0)
#define PG8_LDB(dst, b, h) do { _Pragma("unroll") for (int n = 0; n < 2; ++n) _Pragma("unroll") for (int k = 0; k < 2; ++k) dst[n][k] = *(const PG8_LAS bf16x8*)(lds + PG8_SB(b, h) + boff + n * 2048 + k * 1024); } while (0)
#define PG8_MMA(ai, bj, At, Bt) do { __builtin_amdgcn_s_setprio(1); _Pragma("unroll") for (int m = 0; m < 4; ++m) _Pragma("unroll") for (int n = 0; n < 2; ++n) _Pragma("unroll") for (int k = 0; k < 2; ++k) \
        acc[ai][bj][m][n] = __builtin_amdgcn_mfma_f32_16x16x32_bf16(Bt[n][k], At[m][k], acc[ai][bj][m][n], 0, 0, 0); __builtin_amdgcn_s_setprio(0); } while (0)
#define PG8_WAIT_V(n) asm volatile("s_waitcnt vmcnt(" #n ")" ::: "memory")
#define PG8_WAIT_L(n) asm volatile("s_waitcnt lgkmcnt(" #n ")" ::: "memory")
#define PG8_BAR __builtin_amdgcn_s_barrier()
#define PG8_SCHED __builtin_amdgcn_sched_barrier(0)
    Unit cur, nxt; int ui = 0;
    if (!S.next(0, cur)) return;
    f32x4 acc[2][2][4][2];
#pragma unroll
    for (int a = 0; a < 2; ++a)
#pragma unroll
        for (int b = 0; b < 2; ++b)
#pragma unroll
            for (int m = 0; m < 4; ++m)
#pragma unroll
                for (int n = 0; n < 2; ++n) acc[a][b][m][n] = (f32x4){0.f, 0.f, 0.f, 0.f};
    bf16x8 At[4][2], B0[2][2], B1[2][2];
    const char* cA = (const char*)g.A + (size_t)cur.pm * tstep; const char* cB = (const char*)g.Bt + (size_t)cur.pn * tstep;
    S.a_ready(cur);
    if constexpr (SP2) {
        PG8_STAGE(PG8_SB(0, 0), cB, voffB); PG8_STAGE(PG8_SB(0, 1), cB + hstep, voffB); PG8_STAGE(PG8_SA(0, 0), cA, voffA); PG8_STAGE(PG8_SA(0, 1), cA + hstep, voffA);
        if (wr == 1) PG8_BAR;
        PG8_WAIT_V(2); PG8_BAR;
        PG8_STAGE(PG8_SB(1, 0), cB + kstep, voffB); PG8_STAGE(PG8_SA(1, 0), cA + kstep, voffA); PG8_STAGE(PG8_SB(1, 1), cB + hstep + kstep, voffB);
        PG8_WAIT_V(6); PG8_BAR;
    } else {
        PG8_STAGE(PG8_SB(0, 0), cB, voffB); PG8_STAGE(PG8_SA(0, 0), cA, voffA); PG8_STAGE(PG8_SB(0, 1), cB + hstep, voffB); PG8_STAGE(PG8_SA(0, 1), cA + hstep, voffA);
        if (wr == 1) PG8_BAR;
        PG8_WAIT_V(4); PG8_BAR;
        PG8_STAGE(PG8_SB(1, 0), cB + kstep, voffB); PG8_STAGE(PG8_SA(1, 0), cA + kstep, voffA); PG8_STAGE(PG8_SB(1, 1), cB + hstep + kstep, voffB);
        PG8_WAIT_V(6); PG8_BAR;
    }
    for (;;) {
        const bool has_next = S.next(ui + 1, nxt);
        const char* nA = has_next ? (const char*)g.A + (size_t)nxt.pm * tstep : cA; const char* nB = has_next ? (const char*)g.Bt + (size_t)nxt.pn * tstep : cB;
        for (int t = 0; t < nt; t += 2) {
            const bool last = (t == nt - 2);
            const char* a1 = cA + (size_t)(t + 1) * kstep;
            const char* a2 = last ? nA : cA + (size_t)(t + 2) * kstep; const char* b2 = last ? nB : cB + (size_t)(t + 2) * kstep;
            const char* a3 = a2 + kstep; const char* b3 = b2 + kstep;
            if (last && has_next) S.a_ready(nxt);
            if constexpr (SP2) {
            PG8_LDB(B0, 0, 0); PG8_LDB(B1, 0, 1); PG8_SCHED; PG8_LDA(At, 0, 0); PG8_STAGE(PG8_SA(1, 1), a1 + hstep, voffA);
            PG8_WAIT_V(8); PG8_WAIT_L(0); PG8_BAR; PG8_MMA(0, 0, At, B0); PG8_MMA(0, 1, At, B1); PG8_BAR; PG8_SCHED;
            PG8_LDA(At, 0, 1); PG8_STAGE(PG8_SB(0, 0), b2, voffB); PG8_STAGE(PG8_SB(0, 1), b2 + hstep, voffB); PG8_STAGE(PG8_SA(0, 0), a2, voffA);
            PG8_WAIT_V(8); PG8_WAIT_L(0); PG8_BAR; PG8_MMA(1, 0, At, B0); PG8_MMA(1, 1, At, B1); PG8_BAR; PG8_SCHED;
            PG8_LDB(B0, 1, 0); PG8_LDB(B1, 1, 1); PG8_SCHED; PG8_LDA(At, 1, 0); PG8_STAGE(PG8_SA(0, 1), a2 + hstep, voffA);
            PG8_WAIT_V(8); PG8_WAIT_L(0); PG8_BAR; PG8_MMA(0, 0, At, B0); PG8_MMA(0, 1, At, B1); PG8_BAR; PG8_SCHED;
            PG8_LDA(At, 1, 1); PG8_STAGE(PG8_SB(1, 0), b3, voffB); PG8_STAGE(PG8_SB(1, 1), b3 + hstep, voffB); PG8_STAGE(PG8_SA(1, 0), a3, voffA);
            PG8_WAIT_V(8); PG8_WAIT_L(0); PG8_BAR; PG8_MMA(1, 0, At, B0); PG8_MMA(1, 1, At, B1); PG8_BAR; PG8_SCHED;
            } else {
            PG8_LDB(B0, 0, 0); PG8_SCHED; PG8_LDA(At, 0, 0); PG8_STAGE(PG8_SA(1, 1), a1 + hstep, voffA);
            PG8_WAIT_L(8); PG8_BAR; PG8_WAIT_L(0); PG8_MMA(0, 0, At, B0); PG8_BAR; PG8_SCHED;
            PG8_LDB(B1, 0, 1); PG8_STAGE(PG8_SB(0, 0), b2, voffB);
            PG8_BAR; PG8_WAIT_L(0); PG8_MMA(0, 1, At, B1); PG8_BAR;
            PG8_LDA(At, 0, 1); PG8_STAGE(PG8_SA(0, 0), a2, voffA);
            PG8_BAR; PG8_WAIT_L(0); PG8_MMA(1, 0, At, B0); PG8_BAR; PG8_SCHED;
            PG8_STAGE(PG8_SB(0, 1), b2 + hstep, voffB);
            PG8_WAIT_V(6); PG8_BAR; PG8_MMA(1, 1, At, B1); PG8_BAR;
            PG8_LDB(B0, 1, 0); PG8_SCHED; PG8_LDA(At, 1, 0); PG8_STAGE(PG8_SA(0, 1), a2 + hstep, voffA);
            PG8_WAIT_L(8); PG8_BAR; PG8_WAIT_L(0); PG8_MMA(0, 0, At, B0); PG8_BAR; PG8_SCHED;
            PG8_LDB(B1, 1, 1); PG8_STAGE(PG8_SB(1, 0), b3, voffB);
            PG8_BAR; PG8_WAIT_L(0); PG8_MMA(0, 1, At, B1); PG8_BAR;
            PG8_LDA(At, 1, 1); PG8_STAGE(PG8_SA(1, 0), a3, voffA);
            PG8_BAR; PG8_WAIT_L(0); PG8_MMA(1, 0, At, B0); PG8_BAR; PG8_SCHED;
            PG8_STAGE(PG8_SB(1, 1), b3 + hstep, voffB);
            PG8_WAIT_V(6); PG8_BAR; PG8_MMA(1, 1, At, B1); PG8_BAR;
            }
        }
        if constexpr (ALIGN_EPI) { if (wr == 0) PG8_BAR; }
        if constexpr (!Epi::AFTER_DRAIN) { E(acc, cur, wr, wc, fr, fq); S.done(cur); }
        if (!has_next) break;
#pragma unroll
        for (int a = 0; a < 2; ++a)
#pragma unroll
            for (int b = 0; b < 2; ++b)
#pragma unroll
                for (int m = 0; m < 4; ++m)
#pragma unroll
                    for (int n = 0; n < 2; ++n) acc[a][b][m][n] = (f32x4){0.f, 0.f, 0.f, 0.f};
        cur = nxt; cA = nA; cB = nB; ++ui;
        if constexpr (ALIGN_EPI) { if (wr == 1) PG8_BAR; }
    }
    PG8_WAIT_V(0);
    if constexpr (!ALIGN_EPI) { if (wr == 0) PG8_BAR; }
    PG8_BAR;
    if constexpr (Epi::AFTER_DRAIN) { E.fused(acc, cur, wr, wc, fr, fq, lds, wid, lane); S.done(cur); }
#undef PG8_SA
#undef PG8_SB
#undef PG8_STAGE
#undef PG8_LDA
#undef PG8_LDB
#undef PG8_MMA
#undef PG8_WAIT_V
#undef PG8_WAIT_L
#undef PG8_BAR
#undef PG8_SCHED
}
}

#include <hip/hip_cooperative_groups.h>
namespace cg = cooperative_groups;
#define LAS __attribute__((address_space(3)))
typedef unsigned short bf16;
typedef float f32x4 __attribute__((ext_vector_type(4)));
typedef float f32x2v __attribute__((ext_vector_type(2)));
typedef unsigned u32x2 __attribute__((ext_vector_type(2)));
typedef unsigned u32x4 __attribute__((ext_vector_type(4)));
typedef short bf16x8 __attribute__((ext_vector_type(8)));

constexpr int BATCH = 2, SEQ = 8192, M = BATCH * SEQ, D = 1024, NPROJ = 3584, INCOLS = 3592, FF = 4096;
constexpr int NCH = SEQ / 64;
constexpr float EPS = 1e-6f;
constexpr int NTHR = 512, NWAVES = 8;

constexpr size_t MiB = 1u << 20;
constexpr size_t WS_CTL = 0, CTL_BYTES = 1 * MiB;
constexpr size_t WS_WIN = 2 * MiB, WS_WOUT = 10 * MiB, WS_W1 = 12 * MiB, WS_W2 = 20 * MiB, WS_GB = 28 * MiB, WS_SSQ = 29 * MiB;
constexpr size_t WS_XN = 32 * MiB;
constexpr size_t WS_PROJ = 64 * MiB;
constexpr size_t WS_MIX = 176 * MiB;
constexpr size_t WS_OATT = 208 * MiB;
constexpr size_t WS_ODN = 224 * MiB;
constexpr size_t WS_Z = 64 * MiB;
constexpr size_t WS_END = 256 * MiB;

constexpr int LDS_BYTES = 163840;

__device__ __forceinline__ unsigned f2bf(float f) { unsigned u = __builtin_bit_cast(unsigned, f); return (u + 0x7fffu + ((u >> 16) & 1u)) >> 16; }
__device__ __forceinline__ unsigned pk2(float lo, float hi) { return f2bf(lo) | (f2bf(hi) << 16); }
__device__ __forceinline__ float bflo(unsigned w) { return __builtin_bit_cast(float, w << 16); }
__device__ __forceinline__ float bfhi(unsigned w) { return __builtin_bit_cast(float, w & 0xffff0000u); }
__device__ __forceinline__ float bf2f(bf16 b) { return __builtin_bit_cast(float, (unsigned)b << 16); }
__device__ __forceinline__ float wave_sum(float v) {
#pragma unroll
    for (int o = 1; o < 64; o <<= 1) v += __shfl_xor(v, o);
    return v;
}
typedef float f32x2_t __attribute__((ext_vector_type(2))); typedef __bf16 bf16x2_t __attribute__((ext_vector_type(2)));
__device__ __forceinline__ unsigned cvtpk(float lo, float hi) { f32x2_t v = {lo, hi}; bf16x2_t b = __builtin_convertvector(v, bf16x2_t); return __builtin_bit_cast(unsigned, b); }
__device__ __forceinline__ bf16x8 pack8(const f32x4& a, const f32x4& b) { u32x4 p; p.x = cvtpk(a[0], a[1]); p.y = cvtpk(a[2], a[3]); p.z = cvtpk(b[0], b[1]); p.w = cvtpk(b[2], b[3]); return __builtin_bit_cast(bf16x8, p); }
__device__ __forceinline__ unsigned short f2bf_hw(float x) { return (unsigned short)(cvtpk(x, x) & 0xffffu); }
__device__ __forceinline__ float fexp(float x) { return __builtin_amdgcn_exp2f(x * 1.4426950408889634f); }
__device__ __forceinline__ float frcp(float x) { return __builtin_amdgcn_rcpf(x); }
__device__ __forceinline__ float frsq(float x) { return __builtin_amdgcn_rsqf(x); }
__device__ __forceinline__ float silu_f(float y) { return y * frcp(1.0f + fexp(-y)); }

struct Args {
    const float* in[15]; float* out; unsigned char* ws; int ph_lo, ph_hi;
};

namespace pg8 {
struct EpiResid {
    static constexpr bool PERM = false, AFTER_DRAIN = false;
    const float* base; float* out; bf16_t* hb; float* ssq; int ldc;
    __device__ __forceinline__ void operator()(const f32x4 (&acc)[2][2][4][2], const Unit& u, int wr, int wc, int fr, int fq) const {
        typedef unsigned u32x2v __attribute__((ext_vector_type(2)));
        const int col0 = u.pn * BM + wc * 32 + 4 * fq;
#pragma unroll
        for (int ai = 0; ai < 2; ++ai)
#pragma unroll
            for (int mp = 0; mp < 2; ++mp) {
                f32x4 bs[2][2][2];
#pragma unroll
                for (int mm = 0; mm < 2; ++mm) { const size_t off = (size_t)(u.pm * BM + ai * HALF + wr * 64 + (2 * mp + mm) * 16 + fr) * ldc + col0;
#pragma unroll
                    for (int bj = 0; bj < 2; ++bj)
#pragma unroll
                        for (int n = 0; n < 2; ++n) bs[mm][bj][n] = *(const f32x4*)(base + off + bj * HALF + n * 16); }
                asm volatile("" ::: "memory");
#pragma unroll
                for (int mm = 0; mm < 2; ++mm) { const int m = 2 * mp + mm; const int r = u.pm * BM + ai * HALF + wr * 64 + m * 16 + fr; const size_t off = (size_t)r * ldc + col0; float s = 0.f;
#pragma unroll
                    for (int bj = 0; bj < 2; ++bj)
#pragma unroll
                        for (int n = 0; n < 2; ++n) {
                            const f32x4 o = bs[mm][bj][n] + acc[ai][bj][m][n];
                            if (out) *(f32x4*)(out + off + bj * HALF + n * 16) = o;
                            s += (o[0] * o[0] + o[1] * o[1]) + (o[2] * o[2] + o[3] * o[3]);
                            if (hb) { u32x2v w; w.x = cvt_pk_bf16(o[0], o[1]); w.y = cvt_pk_bf16(o[2], o[3]); *(u32x2v*)(hb + off + bj * HALF + n * 16) = w; }
                        }
                    if (ssq) { s += __shfl_xor(s, 16); s += __shfl_xor(s, 32); if (fq == 0) ssq[(size_t)r * 16 + u.pn * 4 + wc] = s; } }
                asm volatile("" ::: "memory");
            }
    }
};
struct EpiRelu2 {
    static constexpr bool PERM = true, AFTER_DRAIN = false;
    bf16_t* O; int ldc; const float* ssq; float inv_ncol, eps;
    __device__ __forceinline__ void operator()(const f32x4 (&acc)[2][2][4][2], const Unit& u, int wr, int wc, int fr, int fq) const {
        const int row0 = u.pm * BM + wr * 64 + fr; const int col0 = u.pn * BM + wc * 32 + 8 * fq;
        float rsv[2][4];
#pragma unroll
        for (int ai = 0; ai < 2; ++ai)
#pragma unroll
            for (int m = 0; m < 4; ++m) {
                const f32x4* sp = (const f32x4*)(ssq + (size_t)(row0 + ai * HALF + m * 16) * 16);
                const f32x4 s0 = sp[0], s1 = sp[1], s2 = sp[2], s3 = sp[3];
                const float tot = ((s0[0] + s0[1]) + (s0[2] + s0[3])) + ((s1[0] + s1[1]) + (s1[2] + s1[3])) + ((s2[0] + s2[1]) + (s2[2] + s2[3])) + ((s3[0] + s3[1]) + (s3[2] + s3[3]));
                rsv[ai][m] = __builtin_amdgcn_rsqf(tot * inv_ncol + eps);
            }
        asm volatile("" ::: "memory");
#pragma unroll
        for (int ai = 0; ai < 2; ++ai)
#pragma unroll
            for (int m = 0; m < 4; ++m) {
                const float rs = rsv[ai][m];
                bf16_t* rowp = O + (size_t)(row0 + ai * HALF + m * 16) * ldc + col0;
#pragma unroll
                for (int bj = 0; bj < 2; ++bj) {
                    f32x4 v0 = acc[ai][bj][m][0] * rs, v1 = acc[ai][bj][m][1] * rs;
#pragma unroll
                    for (int e = 0; e < 4; ++e) { const float a = fmaxf(v0[e], 0.f), b = fmaxf(v1[e], 0.f); v0[e] = a * a; v1[e] = b * b; }
                    u32x4 w; w.x = cvt_pk_bf16(v0[0], v0[1]); w.y = cvt_pk_bf16(v0[2], v0[3]); w.z = cvt_pk_bf16(v1[0], v1[1]); w.w = cvt_pk_bf16(v1[2], v1[3]);
                    *(u32x4*)(rowp + bj * HALF) = w;
                }
            }
    }
};
struct EpiOutBf {
    static constexpr bool PERM = false, AFTER_DRAIN = false;
    const bf16_t* hb; float* out; int ldc;
    __device__ __forceinline__ void operator()(const f32x4 (&acc)[2][2][4][2], const Unit& u, int wr, int wc, int fr, int fq) const {
        typedef unsigned u32x2v __attribute__((ext_vector_type(2)));
        const int col0 = u.pn * BM + wc * 32 + 4 * fq;
#pragma unroll
        for (int ai = 0; ai < 2; ++ai) {
            u32x2v w[4][2][2];
#pragma unroll
            for (int m = 0; m < 4; ++m) { const size_t off = (size_t)(u.pm * BM + ai * HALF + wr * 64 + m * 16 + fr) * ldc + col0;
#pragma unroll
                for (int bj = 0; bj < 2; ++bj)
#pragma unroll
                    for (int n = 0; n < 2; ++n) w[m][bj][n] = *(const u32x2v*)(hb + off + bj * HALF + n * 16); }
            asm volatile("" ::: "memory");
#pragma unroll
            for (int m = 0; m < 4; ++m) { const size_t off = (size_t)(u.pm * BM + ai * HALF + wr * 64 + m * 16 + fr) * ldc + col0;
#pragma unroll
                for (int bj = 0; bj < 2; ++bj)
#pragma unroll
                    for (int n = 0; n < 2; ++n) {
                        const u32x2v ww = w[m][bj][n];
                        f32x4 bs; bs[0] = __builtin_bit_cast(float, ww.x << 16); bs[1] = __builtin_bit_cast(float, ww.x & 0xffff0000u); bs[2] = __builtin_bit_cast(float, ww.y << 16); bs[3] = __builtin_bit_cast(float, ww.y & 0xffff0000u);
                        *(f32x4*)(out + off + bj * HALF + n * 16) = bs + acc[ai][bj][m][n];
                    } }
            asm volatile("" ::: "memory");
        }
    }
};
}

struct Frame {
    LAS unsigned char* lds;
    int tid, lane, wave, G, gw, NGW;
    const float *x, *mix_gain, *w_in, *q_gain, *k_gain, *rel_bias, *att_out_gain, *conv_w, *a_log, *dt_bias, *dn_out_gain, *w_out, *ffn_gain, *w1, *w2;
    float* out;
    bf16 *WIN_T, *WOUT_T, *W1_T, *W2_T, *XN, *H1B, *PROJ, *MIX, *OATT, *Z, *WKI, *UI, *SnI, *QdI, *AttI, *TinvI;
    float *GB, *SSQ, *CD;
};

__device__ __forceinline__ void transpose_item(const float* W, int ldw, int K, int ncols, const float* kgain, bf16* WT, LAS float* scr, int item, int lane) {
    const int nblk = ncols / 32, kb = item / nblk, nb = item % nblk, k0 = 64 * kb, n0 = 32 * nb;
#pragma unroll
    for (int i = 0; i < 32; ++i) { const int kk = 2 * i + (lane >> 5); float w = W[(size_t)(k0 + kk) * ldw + n0 + (lane & 31)]; if (kgain) w *= kgain[k0 + kk]; scr[kk * 33 + (lane & 31)] = w; }
    asm volatile("s_waitcnt lgkmcnt(0)" ::: "memory");
    const int c = lane & 7;
#pragma unroll
    for (int j = 0; j < 4; ++j) { const int n = (lane >> 3) + 8 * j; const LAS float* s = scr + (8 * c) * 33 + n;
        u32x4 o; o.x = cvtpk(s[0 * 33], s[1 * 33]); o.y = cvtpk(s[2 * 33], s[3 * 33]); o.z = cvtpk(s[4 * 33], s[5 * 33]); o.w = cvtpk(s[6 * 33], s[7 * 33]);
        *(u32x4*)(WT + (size_t)(n0 + n) * K + k0 + 8 * c) = o; }
    asm volatile("s_waitcnt lgkmcnt(0)" ::: "memory");
}

__device__ __forceinline__ void weights_rest(Frame& F, int wv, int nwv) {
    LAS float* scr = (LAS float*)(F.lds + F.wave * 8448);
    constexpr int I_O = (D / 64) * (D / 32), I_1 = (D / 64) * (FF / 32), I_2 = (FF / 64) * (D / 32);
    for (int it = wv; it < I_O + I_1 + I_2; it += nwv) {
        int r = it;
        if (r < I_O) { transpose_item(F.w_out, D, D, D, nullptr, F.WOUT_T, scr, r, F.lane); continue; } r -= I_O;
        if (r < I_1) { transpose_item(F.w1, FF, D, FF, F.ffn_gain, F.W1_T, scr, r, F.lane); continue; } r -= I_1;
        transpose_item(F.w2, D, FF, D, nullptr, F.W2_T, scr, r, F.lane);
    }
}

__device__ __forceinline__ void p0_row(Frame& F, int r, const f32x4 (&v)[4], const f32x4 (&gq)[4], const LAS float* w8, float dtb, float ealg, int ccol) {
    const int lane = F.lane;
    float ss = 0.f;
#pragma unroll
    for (int j = 0; j < 4; ++j) ss += (v[j][0] * v[j][0] + v[j][1] * v[j][1]) + (v[j][2] * v[j][2] + v[j][3] * v[j][3]);
    ss = wave_sum(ss);
    const float rstd = frsq(ss * (1.0f / D) + EPS);
    float ds[8];
#pragma unroll
    for (int c = 0; c < 8; ++c) ds[c] = 0.f;
#pragma unroll
    for (int j = 0; j < 4; ++j) {
        const f32x4 u = v[j] * rstd * gq[j];
        u32x2 w; w.x = cvtpk(u[0], u[1]); w.y = cvtpk(u[2], u[3]);
        *(u32x2*)(F.XN + (size_t)r * D + 256 * j + 4 * lane) = w;
#pragma unroll
        for (int e = 0; e < 4; ++e) {
            const int k = 256 * j + 4 * lane + e;
            const f32x4 w0 = *(const LAS f32x4*)(w8 + k * 8), w1 = *(const LAS f32x4*)(w8 + k * 8 + 4);
#pragma unroll
            for (int c = 0; c < 4; ++c) { ds[c] += u[e] * w0[c]; ds[4 + c] += u[e] * w1[c]; }
        }
    }
    const bool b5 = (lane & 32) != 0, b4 = (lane & 16) != 0, b3 = (lane & 8) != 0;
    float e4[4], e2[2];
#pragma unroll
    for (int c = 0; c < 4; ++c) { const float snd = b5 ? ds[c] : ds[4 + c], kp = b5 ? ds[4 + c] : ds[c]; e4[c] = kp + __shfl_xor(snd, 32); }
#pragma unroll
    for (int c = 0; c < 2; ++c) { const float snd = b4 ? e4[c] : e4[2 + c], kp = b4 ? e4[2 + c] : e4[c]; e2[c] = kp + __shfl_xor(snd, 16); }
    float d;
    { const float snd = b3 ? e2[0] : e2[1], kp = b3 ? e2[1] : e2[0]; d = kp + __shfl_xor(snd, 8); }
    d += __shfl_xor(d, 4); d += __shfl_xor(d, 2); d += __shfl_xor(d, 1);
    if ((lane & 7) == 0) {
        float val;
        if (ccol < 4) { const float a = d + dtb; const float sp = fmaxf(a, 0.f) + __builtin_amdgcn_logf(1.0f + fexp(-fabsf(a))) * 0.6931471805599453f; val = -ealg * sp; }
        else val = frcp(1.0f + fexp(-d));
        F.GB[(size_t)r * 8 + ccol] = val;
    }
}

__device__ __forceinline__ void p0_prologue(Frame& F) {
    LAS float* w8 = (LAS float*)(F.lds + 69632);
#pragma unroll
    for (int q = 0; q < 16; ++q) { const int i = F.tid + q * NTHR; w8[i] = F.w_in[(size_t)(i >> 3) * INCOLS + NPROJ + (i & 7)]; }
    __syncthreads();
    const int lane = F.lane;
    f32x4 gq[4];
#pragma unroll
    for (int j = 0; j < 4; ++j) gq[j] = ((const f32x4*)F.mix_gain)[lane + 64 * j];
    const int ccol = ((lane >> 5) & 1) * 4 + ((lane >> 4) & 1) * 2 + ((lane >> 3) & 1);
    const float dtb = F.dt_bias[ccol & 3], ealg = expf(F.a_log[ccol & 3]);
#define P0_LOAD(buf, rr) do { if ((rr) < M) { _Pragma("unroll") for (int j = 0; j < 4; ++j) buf[j] = ((const f32x4*)(F.x + (size_t)(rr) * D) + lane)[64 * j]; } } while (0)
    f32x4 xa[4], xb[4], xc[4];
    P0_LOAD(xa, F.gw); P0_LOAD(xb, F.gw + F.NGW); P0_LOAD(xc, F.gw + 2 * F.NGW);
    for (int r = F.gw; r < M; r += 3 * F.NGW) {
        p0_row(F, r, xa, gq, w8, dtb, ealg, ccol); P0_LOAD(xa, r + 3 * F.NGW);
        if (r + F.NGW < M) { p0_row(F, r + F.NGW, xb, gq, w8, dtb, ealg, ccol); P0_LOAD(xb, r + 4 * F.NGW); }
        if (r + 2 * F.NGW < M) { p0_row(F, r + 2 * F.NGW, xc, gq, w8, dtb, ealg, ccol); P0_LOAD(xc, r + 5 * F.NGW); }
    }
#undef P0_LOAD
    LAS float* scr = (LAS float*)(F.lds + F.wave * 8448);
    constexpr int I_IN = (D / 64) * (NPROJ / 32);
    for (int it = F.gw; it < I_IN; it += F.NGW) transpose_item(F.w_in, INCOLS, D, NPROJ, nullptr, F.WIN_T, scr, it, lane);
    if (F.G != 256) weights_rest(F, F.gw, F.NGW);
}

#define LDSBAR() asm volatile("s_waitcnt lgkmcnt(0)\n\ts_barrier" ::: "memory")
#define MFMA16(a, b, c) __builtin_amdgcn_mfma_f32_16x16x32_bf16((a), (b), (c), 0, 0, 0)

constexpr int PST = 132;
constexpr int AST = 68;
__device__ __forceinline__ bf16x8 ld8cvt(const LAS float* p) { const f32x4 a = *(const LAS f32x4*)p, b = *(const LAS f32x4*)(p + 4); return pack8(a, b); }
__device__ __forceinline__ void dn_prep_unit(Frame& F, int unit) {
    const int n = unit & 127, bh = unit >> 7, h = bh & 3, b = bh >> 2;
    const int tid = F.tid, lane = F.lane, wave = F.wave;
    const size_t row0 = (size_t)b * SEQ + (size_t)n * 64;
    LAS float* qf = (LAS float*)F.lds;
    LAS float* kf = qf + 64 * PST;
    LAS float* vf = kf + 64 * PST;
    LAS float* Am = vf + 64 * PST;
    LAS float* An = Am + 64 * AST;
    LAS float* dL = An + 64 * AST;
    LAS float* bL = dL + 64;
    LAS bf16* AttL = (LAS bf16*)(bL + 64);
    if (tid < 384) {
        const int rg = tid / 48, cc = tid - rg * 48, mat = cc >> 4, c8 = (cc & 15) * 8, ch = mat * 512 + h * 128 + c8;
        const bf16* src = F.PROJ + (row0 + 8 * rg) * NPROJ + 1536 + ch;
        u32x4 raw[11];
#pragma unroll
        for (int i = 0; i < 11; ++i) {
            if (i < 3 && n == 0 && rg == 0) raw[i] = (u32x4){0u, 0u, 0u, 0u};
            else raw[i] = *(const u32x4*)(src + ((ptrdiff_t)i - 3) * (ptrdiff_t)NPROJ);
        }
        f32x4 wa[4], wb[4];
#pragma unroll
        for (int j = 0; j < 4; ++j) { wa[j] = *(const f32x4*)(F.conv_w + j * 1536 + ch); wb[j] = *(const f32x4*)(F.conv_w + j * 1536 + ch + 4); }
        LAS float* dst = qf + mat * (64 * PST) + (8 * rg) * PST + c8;
        const float qsc = (mat == 0) ? 0.08838834764831845f : 1.0f;
        f32x4 ya[8], yb[8]; float ss[8];
#pragma unroll
        for (int i = 0; i < 8; ++i) {
            ya[i] = (f32x4){0.f, 0.f, 0.f, 0.f}; yb[i] = (f32x4){0.f, 0.f, 0.f, 0.f};
#pragma unroll
            for (int j = 0; j < 4; ++j) {
                const u32x4 w = raw[i + j];
                ya[i] += wa[j] * (f32x4){bflo(w.x), bfhi(w.x), bflo(w.y), bfhi(w.y)};
                yb[i] += wb[j] * (f32x4){bflo(w.z), bfhi(w.z), bflo(w.w), bfhi(w.w)};
            }
#pragma unroll
            for (int e = 0; e < 4; ++e) { ya[i][e] = silu_f(ya[i][e]); yb[i][e] = silu_f(yb[i][e]); }
            ss[i] = (ya[i][0] * ya[i][0] + ya[i][1] * ya[i][1]) + (ya[i][2] * ya[i][2] + ya[i][3] * ya[i][3]) + (yb[i][0] * yb[i][0] + yb[i][1] * yb[i][1]) + (yb[i][2] * yb[i][2] + yb[i][3] * yb[i][3]);
        }
        if (mat < 2) {
#pragma unroll
            for (int o = 1; o < 16; o <<= 1) {
                float t[8];
#pragma unroll
                for (int i = 0; i < 8; ++i) t[i] = __shfl_xor(ss[i], o);
#pragma unroll
                for (int i = 0; i < 8; ++i) ss[i] += t[i];
            }
#pragma unroll
            for (int i = 0; i < 8; ++i) { const float sc = frsq(ss[i] + EPS) * qsc; ya[i] = ya[i] * sc; yb[i] = yb[i] * sc; }
        }
#pragma unroll
        for (int i = 0; i < 8; ++i) { *(LAS f32x4*)(dst + i * PST) = ya[i]; *(LAS f32x4*)(dst + i * PST + 4) = yb[i]; }
    } else if (wave == 7) {
#pragma unroll 8
        for (int row = 0; row < 64; ++row) Am[row * AST + lane] = (row == lane) ? 1.0f : 0.0f;
    } else if (wave == 6) {
        float v = F.GB[(row0 + lane) * 8 + h];
#pragma unroll
        for (int o = 1; o < 64; o <<= 1) { const float t = __shfl_up(v, o); if (lane >= o) v += t; }
        dL[lane] = v; bL[lane] = F.GB[(row0 + lane) * 8 + 4 + h];
    }
    LDSBAR();
    {
        const int c = lane & 15, g = lane >> 4, mi = wave >> 1, nj0 = 2 * (wave & 1);
        bf16x8 ak[4], aq[4];
#pragma unroll
        for (int kk = 0; kk < 4; ++kk) { ak[kk] = ld8cvt(kf + (16 * mi + c) * PST + 32 * kk + 8 * g); aq[kk] = ld8cvt(qf + (16 * mi + c) * PST + 32 * kk + 8 * g); }
#pragma unroll
        for (int t = 0; t < 2; ++t) {
            const int nj = nj0 + t;
            f32x4 kk4 = {0.f, 0.f, 0.f, 0.f}, qk4 = {0.f, 0.f, 0.f, 0.f};
#pragma unroll
            for (int kk = 0; kk < 4; ++kk) { const bf16x8 bb = ld8cvt(kf + (16 * nj + c) * PST + 32 * kk + 8 * g); kk4 = MFMA16(ak[kk], bb, kk4); qk4 = MFMA16(aq[kk], bb, qk4); }
            const int j = 16 * nj + c; const float dj = dL[j];
#pragma unroll
            for (int e = 0; e < 4; ++e) {
                const int i = 16 * mi + 4 * g + e; const float di = dL[i], bi = bL[i];
                const float ex = fexp(fminf(di - dj, 0.f));
                const float aij = (j < i) ? bi * kk4[e] * ex : 0.f;
                An[i * AST + j] = aij;
                AttL[i * 64 + j] = (bf16)f2bf_hw((j <= i) ? qk4[e] * ex : 0.f);
            }
        }
    }
    LDSBAR();
    {
        LAS float* Ti = Am;
        const float dlast = dL[63];
        if (wave == 0) {
            const int cl = lane & 15, g = lane >> 4;
#pragma unroll
            for (int b4 = 0; b4 < 4; ++b4) {
                const int i0 = 16 * b4;
                if (b4 > 0) {
                    f32x4 acc3[3] = {{0.f, 0.f, 0.f, 0.f}, {0.f, 0.f, 0.f, 0.f}, {0.f, 0.f, 0.f, 0.f}};
#pragma unroll
                    for (int ks = 0; ks < (b4 == 3 ? 2 : 1); ++ks) {
                        const bool valid = (32 * ks + 8 * g) < i0;
                        const LAS float* ap = An + (i0 + cl) * AST + 32 * ks + 8 * g;
                        f32x4 a0 = *(const LAS f32x4*)ap, a1 = *(const LAS f32x4*)(ap + 4);
                        if (!valid) { a0 = (f32x4){0.f, 0.f, 0.f, 0.f}; a1 = a0; }
                        const bf16x8 Ah = pack8(a0, a1);
#pragma unroll
                        for (int ct = 0; ct < 3; ++ct) if (ct < b4) {
                            const LAS float* xp = Ti + (32 * ks + 8 * g) * AST + 16 * ct + cl;
                            f32x4 x0, x1;
#pragma unroll
                            for (int jj = 0; jj < 4; ++jj) { x0[jj] = xp[jj * AST]; x1[jj] = xp[(4 + jj) * AST]; }
                            acc3[ct] = MFMA16(Ah, pack8(x0, x1), acc3[ct]);
                        }
                    }
#pragma unroll
                    for (int ct = 0; ct < 3; ++ct) if (ct < b4) {
                        LAS float* rp = Ti + (i0 + 4 * g) * AST + 16 * ct + cl;
#pragma unroll
                        for (int e = 0; e < 4; ++e) rp[e * AST] -= acc3[ct][e];
                    }
                }
                LAS float* X = Ti + i0 * AST + lane;
                float x[16];
                f32x4 ac[16][4];
#pragma unroll
                for (int r = 0; r < 16; ++r) x[r] = X[r * AST];
#pragma unroll
                for (int r = 1; r < 16; ++r)
#pragma unroll
                    for (int q4 = 0; q4 < (r + 3) / 4; ++q4) ac[r][q4] = *(const LAS f32x4*)(An + (i0 + r) * AST + i0 + 4 * q4);
                __builtin_amdgcn_sched_barrier(0);
#pragma unroll
                for (int r = 1; r < 16; ++r)
#pragma unroll
                    for (int q4 = 0; q4 < (r + 3) / 4; ++q4)
#pragma unroll
                        for (int e = 0; e < 4; ++e) if (4 * q4 + e < r) x[r] -= ac[r][q4][e] * x[4 * q4 + e];
#pragma unroll
                for (int r = 0; r < 16; ++r) X[r * AST] = x[r];
            }
        } else {
            const int t7 = tid - 64;
#pragma unroll 1
            for (int idx = t7; idx < 1024; idx += 448) {
                const int f = idx >> 6, l = idx & 63, r = l & 15, g = l >> 4, m = f >> 2, s = f & 3, tok = 16 * m + r;
                const float e = fexp(dL[tok]); const LAS float* sp = qf + tok * PST + 32 * s + 4 * g;
                const f32x4 lo = *(const LAS f32x4*)sp * e, hi = *(const LAS f32x4*)(sp + 16) * e;
                *(bf16x8*)(F.QdI + (size_t)unit * 8192 + (size_t)idx * 8) = pack8(lo, hi);
            }
#pragma unroll 1
            for (int idx = t7; idx < 1024; idx += 448) {
                const int f = idx >> 6, l = idx & 63, r = l & 15, g = l >> 4, m = f >> 2, s = f & 3, tok = 16 * m + r;
                const float e = -bL[tok] * fexp(dL[tok]); const LAS float* sp = kf + tok * PST + 32 * s + 4 * g;
                const f32x4 lo = *(const LAS f32x4*)sp * e, hi = *(const LAS f32x4*)(sp + 16) * e;
                *(bf16x8*)(F.WKI + (size_t)unit * 16384 + (size_t)idx * 8) = pack8(lo, hi);
            }
#pragma unroll 1
            for (int idx = t7; idx < 1024; idx += 448) {
                const int f = idx >> 6, l = idx & 63, r = l & 15, g = l >> 4, T = f >> 1, s2 = f & 1, dk = 16 * T + r;
                float v[8];
#pragma unroll
                for (int j = 0; j < 8; ++j) { const int tok = 32 * s2 + 16 * (j >> 2) + 4 * g + (j & 3); v[j] = kf[tok * PST + dk] * fexp(dlast - dL[tok]); }
                u32x4 o; o.x = cvtpk(v[0], v[1]); o.y = cvtpk(v[2], v[3]); o.z = cvtpk(v[4], v[5]); o.w = cvtpk(v[6], v[7]);
                *(u32x4*)(F.WKI + (size_t)unit * 16384 + 8192 + (size_t)idx * 8) = o;
            }
#pragma unroll 1
            for (int idx = t7; idx < 1024; idx += 448) {
                const int f = idx >> 6, l = idx & 63, c = l & 15, g = l >> 4, w = f >> 1, s2 = f & 1, dv = 16 * w + c;
                float v[8];
#pragma unroll
                for (int j = 0; j < 8; ++j) { const int tok = 32 * s2 + 16 * (j >> 2) + 4 * g + (j & 3); v[j] = vf[tok * PST + dv] * bL[tok]; }
                u32x4 o; o.x = cvtpk(v[0], v[1]); o.y = cvtpk(v[2], v[3]); o.z = cvtpk(v[4], v[5]); o.w = cvtpk(v[6], v[7]);
                *(u32x4*)(F.UI + (size_t)unit * 8192 + (size_t)idx * 8) = o;
            }
#pragma unroll 1
            for (int idx = t7; idx < 512; idx += 448) {
                const int f = idx >> 6, l = idx & 63, r = l & 15, g = l >> 4, m = f >> 1, s2 = f & 1, tok = 16 * m + r;
                const LAS bf16* sp = AttL + tok * 64 + 32 * s2 + 4 * g;
                const u32x2 lo = *(const LAS u32x2*)sp, hi = *(const LAS u32x2*)(sp + 16);
                u32x4 o; o.x = lo.x; o.y = lo.y; o.z = hi.x; o.w = hi.y;
                *(u32x4*)(F.AttI + (size_t)unit * 4096 + (size_t)idx * 8) = o;
            }
            if (t7 == 0) F.CD[unit] = fexp(dlast);
        }
        LDSBAR();
        {
            const int idx = tid, f = idx >> 6, l = idx & 63, r = l & 15, g = l >> 4, m = f >> 1, s2 = f & 1, tok = 16 * m + r;
            const LAS float* sp = Ti + tok * AST + 32 * s2 + 4 * g;
            const f32x4 lo = *(const LAS f32x4*)sp, hi = *(const LAS f32x4*)(sp + 16);
            *(bf16x8*)(F.TinvI + (size_t)unit * 4096 + (size_t)idx * 8) = pack8(lo, hi);
        }
    }
    LDSBAR();
}

__device__ __forceinline__ void dn_scan(Frame& F, int sblk) {
    constexpr int STG = 38 * 1024;
    const int bh = sblk >> 2, qd = sblk & 3, wave = F.wave, lane = F.lane;
    const bf16* WK = F.WKI + (size_t)bh * 128 * 16384;
    if (wave >= 4) {
        const int lw = wave - 4;
        const bf16* TQ = F.TinvI + (size_t)bh * 128 * 4096;
#define SCAN_ISSUE(nn) do { _Pragma("unroll") for (int q_ = 0; q_ < 10; ++q_) { const int f_ = lw + 4 * q_; if (f_ < 38) { \
            const int tf_ = f_ - 32, gt_ = (tf_ < 3) ? 2 * tf_ : tf_ + 2;                   \
            const bf16* src_ = (f_ < 32) ? (WK + (size_t)(nn) * 16384 + f_ * 512) : (TQ + (size_t)(nn) * 4096 + gt_ * 512); \
            __builtin_amdgcn_global_load_lds((const unsigned*)(src_ + lane * 8), (LAS unsigned*)(F.lds + ((nn) & 3) * STG + f_ * 1024), 16, 0, 0); } } } while (0)
        SCAN_ISSUE(0); SCAN_ISSUE(1); SCAN_ISSUE(2);
        if (lw < 2) asm volatile("s_waitcnt vmcnt(20)" ::: "memory"); else asm volatile("s_waitcnt vmcnt(18)" ::: "memory");
        __builtin_amdgcn_s_barrier();
#pragma unroll 1
        for (int n = 0; n < NCH; ++n) {
            if (n + 3 < NCH) { SCAN_ISSUE(n + 3); if (lw < 2) asm volatile("s_waitcnt vmcnt(20)" ::: "memory"); else asm volatile("s_waitcnt vmcnt(18)" ::: "memory"); }
            else asm volatile("s_waitcnt vmcnt(0)" ::: "memory");
            __builtin_amdgcn_s_barrier();
        }
#undef SCAN_ISSUE
    } else if (wave < 2) {
        const int w = 2 * qd + wave;
        bf16* UIb = F.UI + (size_t)bh * 128 * 8192 + w * 1024 + lane * 8;
        bf16* SnIb = F.SnI + (size_t)bh * 128 * 16384 + w * 2048 + lane * 8;
        const float cdv0 = F.CD[bh * 128 + lane], cdv1 = F.CD[bh * 128 + 64 + lane];
        f32x4 Sacc[8];
#pragma unroll
        for (int T = 0; T < 8; ++T) Sacc[T] = (f32x4){0.f, 0.f, 0.f, 0.f};
#define SCAN_LD(B0, B1, nn) do { const int n_ = ((nn) < NCH) ? (nn) : NCH - 1; B0 = *(const u32x4*)(UIb + (size_t)n_ * 8192); B1 = *(const u32x4*)(UIb + (size_t)n_ * 8192 + 512); } while (0)
#define SCAN_STEP(nq, u0, u1) do { const int n = (nq); \
            bf16x8 Sb[4]; \
            _Pragma("unroll") for (int s = 0; s < 4; ++s) { Sb[s] = pack8(Sacc[2 * s], Sacc[2 * s + 1]); *(bf16x8*)(SnIb + (size_t)n * 16384 + s * 512) = Sb[s]; } \
            const float cd = __builtin_bit_cast(float, __builtin_amdgcn_readlane(__builtin_bit_cast(int, (n < 64) ? cdv0 : cdv1), n & 63)); \
            const LAS unsigned char* slot = F.lds + (n & 3) * STG + lane * 16; \
            f32x4 Yacc[4]; \
            Yacc[0] = (f32x4){bflo(u0.x), bfhi(u0.x), bflo(u0.y), bfhi(u0.y)}; Yacc[1] = (f32x4){bflo(u0.z), bfhi(u0.z), bflo(u0.w), bfhi(u0.w)}; \
            Yacc[2] = (f32x4){bflo(u1.x), bfhi(u1.x), bflo(u1.y), bfhi(u1.y)}; Yacc[3] = (f32x4){bflo(u1.z), bfhi(u1.z), bflo(u1.w), bfhi(u1.w)}; \
            _Pragma("unroll") for (int s = 0; s < 4; ++s) \
                _Pragma("unroll") for (int m = 0; m < 4; ++m) { const bf16x8 a = *(const LAS bf16x8*)(slot + (m * 4 + s) * 1024); Yacc[m] = MFMA16(a, Sb[s], Yacc[m]); } \
            bf16x8 Yb[2]; \
            _Pragma("unroll") for (int s2 = 0; s2 < 2; ++s2) Yb[s2] = pack8(Yacc[2 * s2], Yacc[2 * s2 + 1]); \
            f32x4 Vacc[4]; const f32x4 zero4 = {0.f, 0.f, 0.f, 0.f}; \
            Vacc[0] = MFMA16(*(const LAS bf16x8*)(slot + 32 * 1024), Yb[0], zero4); \
            Vacc[1] = MFMA16(*(const LAS bf16x8*)(slot + 33 * 1024), Yb[0], zero4); \
            Vacc[2] = MFMA16(*(const LAS bf16x8*)(slot + 34 * 1024), Yb[0], zero4); Vacc[2] = MFMA16(*(const LAS bf16x8*)(slot + 35 * 1024), Yb[1], Vacc[2]); \
            Vacc[3] = MFMA16(*(const LAS bf16x8*)(slot + 36 * 1024), Yb[0], zero4); Vacc[3] = MFMA16(*(const LAS bf16x8*)(slot + 37 * 1024), Yb[1], Vacc[3]); \
            bf16x8 Vb[2]; \
            _Pragma("unroll") for (int s2 = 0; s2 < 2; ++s2) { Vb[s2] = pack8(Vacc[2 * s2], Vacc[2 * s2 + 1]); *(bf16x8*)(UIb + (size_t)n * 8192 + s2 * 512) = Vb[s2]; } \
            _Pragma("unroll") for (int T = 0; T < 8; ++T) Sacc[T] = Sacc[T] * cd; \
            _Pragma("unroll") for (int s2 = 0; s2 < 2; ++s2) \
                _Pragma("unroll") for (int T = 0; T < 8; ++T) { const bf16x8 a = *(const LAS bf16x8*)(slot + (16 + T * 2 + s2) * 1024); Sacc[T] = MFMA16(a, Vb[s2], Sacc[T]); } \
            asm volatile("s_waitcnt lgkmcnt(0)" ::: "memory"); \
            __builtin_amdgcn_s_barrier(); asm volatile("" ::: "memory"); } while (0)
        u32x4 ua0, ua1, ub0, ub1, uc0, uc1;
        SCAN_LD(ua0, ua1, 0); SCAN_LD(ub0, ub1, 1); SCAN_LD(uc0, uc1, 2);
        __builtin_amdgcn_s_barrier();
        asm volatile("" ::: "memory");
#pragma unroll 1
        for (int n3 = 0; n3 < NCH - 2; n3 += 3) {
            SCAN_STEP(n3, ua0, ua1); SCAN_LD(ua0, ua1, n3 + 3);
            SCAN_STEP(n3 + 1, ub0, ub1); SCAN_LD(ub0, ub1, n3 + 4);
            SCAN_STEP(n3 + 2, uc0, uc1); SCAN_LD(uc0, uc1, n3 + 5);
        }
        SCAN_STEP(NCH - 2, ua0, ua1);
        SCAN_STEP(NCH - 1, ub0, ub1);
#undef SCAN_STEP
#undef SCAN_LD
    } else {
        __builtin_amdgcn_s_barrier();
#pragma unroll 1
        for (int n = 0; n < NCH; ++n) __builtin_amdgcn_s_barrier();
    }
    asm volatile("s_waitcnt vmcnt(0) lgkmcnt(0)" ::: "memory");
    __syncthreads();
}

__device__ __forceinline__ void dn_out_task(Frame& F, int task) {
    const int unit = task >> 2, m = task & 3, n = unit & 127, bh = unit >> 7, h = bh & 3, b = bh >> 2, lane = F.lane, c = lane & 15, g = lane >> 4;
    const size_t row0 = (size_t)b * SEQ + (size_t)n * 64 + 16 * m + 4 * g;
    const bf16* Qd = F.QdI + (size_t)unit * 8192 + (size_t)(m * 4) * 512 + lane * 8; const bf16* At = F.AttI + (size_t)unit * 4096 + (size_t)(m * 2) * 512 + lane * 8;
    const bf16* Sn = F.SnI + (size_t)unit * 16384 + lane * 8; const bf16* Vn = F.UI + (size_t)unit * 8192 + lane * 8;
    bf16x8 aq[4], aa[2], bc[6], bn[6];
#pragma unroll
    for (int s = 0; s < 4; ++s) aq[s] = *(const bf16x8*)(Qd + s * 512);
#pragma unroll
    for (int s2 = 0; s2 < 2; ++s2) aa[s2] = *(const bf16x8*)(At + s2 * 512);
#pragma unroll
    for (int s = 0; s < 4; ++s) bc[s] = *(const bf16x8*)(Sn + s * 512);
#pragma unroll
    for (int s2 = 0; s2 < 2; ++s2) bc[4 + s2] = *(const bf16x8*)(Vn + s2 * 512);
    const bf16* gp = F.PROJ + row0 * NPROJ + 3072 + h * 128 + c;
    bf16 graw[4][8];
#pragma unroll
    for (int i = 0; i < 4; ++i)
#pragma unroll
        for (int w = 0; w < 8; ++w) graw[i][w] = gp[(size_t)i * NPROJ + 16 * w];
    float gnv[8];
#pragma unroll
    for (int w = 0; w < 8; ++w) gnv[w] = F.dn_out_gain[16 * w + c];
    __builtin_amdgcn_sched_barrier(0);
    f32x4 O[8]; float ssq[4] = {0.f, 0.f, 0.f, 0.f};
#pragma unroll
    for (int w = 0; w < 8; ++w) {
        if (w < 7) {
#pragma unroll
            for (int s = 0; s < 4; ++s) bn[s] = *(const bf16x8*)(Sn + (w + 1) * 2048 + s * 512);
#pragma unroll
            for (int s2 = 0; s2 < 2; ++s2) bn[4 + s2] = *(const bf16x8*)(Vn + (w + 1) * 1024 + s2 * 512);
        }
        __builtin_amdgcn_sched_barrier(0);
        f32x4 acc = {0.f, 0.f, 0.f, 0.f};
#pragma unroll
        for (int s = 0; s < 4; ++s) acc = MFMA16(aq[s], bc[s], acc);
#pragma unroll
        for (int s2 = 0; s2 < 2; ++s2) acc = MFMA16(aa[s2], bc[4 + s2], acc);
        O[w] = acc;
#pragma unroll
        for (int i = 0; i < 4; ++i) ssq[i] += acc[i] * acc[i];
#pragma unroll
        for (int q = 0; q < 6; ++q) bc[q] = bn[q];
        __builtin_amdgcn_sched_barrier(0);
    }
    float rs[4];
#pragma unroll
    for (int i = 0; i < 4; ++i) { float sq = ssq[i]; sq += __shfl_xor(sq, 1); sq += __shfl_xor(sq, 2); sq += __shfl_xor(sq, 4); sq += __shfl_xor(sq, 8); rs[i] = frsq(sq * (1.0f / 128) + EPS); }
    bf16* mp = F.MIX + row0 * D + 512 + h * 128 + c;
#pragma unroll
    for (int w = 0; w < 8; ++w)
#pragma unroll
        for (int i = 0; i < 4; ++i) mp[(size_t)i * D + 16 * w] = (bf16)f2bf_hw(O[w][i] * rs[i] * gnv[w] * silu_f(bf2f(graw[i][w])));
}

__device__ __forceinline__ void finalize_att_rows(Frame& F) {
    const int lane = F.lane;
    const f32x4 g0 = *(const f32x4*)(F.att_out_gain + 8 * lane), g1 = *(const f32x4*)(F.att_out_gain + 8 * lane + 4);
    for (int r0 = F.gw; r0 < M; r0 += 4 * F.NGW) {
        u32x4 w[4];
#pragma unroll
        for (int q = 0; q < 4; ++q) { const int r = r0 + q * F.NGW; w[q] = (r < M) ? *(const u32x4*)(F.OATT + (size_t)r * 512 + 8 * lane) : (u32x4){0u, 0u, 0u, 0u}; }
#pragma unroll
        for (int q = 0; q < 4; ++q) {
            const int r = r0 + q * F.NGW;
            float v[8];
#pragma unroll
            for (int e = 0; e < 4; ++e) { v[2 * e] = bflo(w[q][e]); v[2 * e + 1] = bfhi(w[q][e]); }
            float ss = 0.f;
#pragma unroll
            for (int e = 0; e < 8; ++e) ss += v[e] * v[e];
            ss = wave_sum(ss);
            const float rs = frsq(ss * (1.0f / 512) + EPS);
            u32x4 o; o.x = cvtpk(v[0] * rs * g0[0], v[1] * rs * g0[1]); o.y = cvtpk(v[2] * rs * g0[2], v[3] * rs * g0[3]); o.z = cvtpk(v[4] * rs * g1[0], v[5] * rs * g1[1]); o.w = cvtpk(v[6] * rs * g1[2], v[7] * rs * g1[3]);
            if (r < M) *(u32x4*)(F.MIX + (size_t)r * D + 8 * lane) = o;
        }
    }
}

typedef short v4i16_t __attribute__((ext_vector_type(4)));
constexpr float LOG2E = 1.4426950408889634f;
constexpr int ATT_K = 0, ATT_V = 73728, ATT_BIAS = 147456;
__device__ __forceinline__ v4i16_t vtr(const LAS unsigned char* p) { return __builtin_amdgcn_ds_read_tr16_b64_v4i16((LAS v4i16_t*)p); }
__device__ __forceinline__ void attn_store_kv(LAS unsigned char* Ks, LAS unsigned char* Vs, int key, int ch, const u32x4& kw, const u32x4& vw, const f32x4& kg0, const f32x4& kg1) {
    float kv[8];
#pragma unroll
    for (int e = 0; e < 4; ++e) { kv[2 * e] = bflo(kw[e]); kv[2 * e + 1] = bfhi(kw[e]); }
    float ss = 0.f;
#pragma unroll
    for (int e = 0; e < 8; ++e) ss += kv[e] * kv[e];
    ss += __shfl_xor(ss, 1); ss += __shfl_xor(ss, 2); ss += __shfl_xor(ss, 4);
    const float rk = frsq(ss * (1.0f / 64) + EPS);
    u32x4 o; o.x = cvtpk(kv[0] * rk * kg0[0], kv[1] * rk * kg0[1]); o.y = cvtpk(kv[2] * rk * kg0[2], kv[3] * rk * kg0[3]); o.z = cvtpk(kv[4] * rk * kg1[0], kv[5] * rk * kg1[1]); o.w = cvtpk(kv[6] * rk * kg1[2], kv[7] * rk * kg1[3]);
    *(LAS u32x4*)(Ks + key * 128 + ((ch ^ (key & 7)) << 4)) = o;
    *(LAS u32x4*)(Vs + key * 128 + ((((ch >> 1) ^ ((key >> 1) & 3)) << 5) + ((ch & 1) << 4))) = vw;
}
constexpr int ATT_ML = ATT_BIAS + 4 * 324 * 4;
constexpr int ATT_SCR = ATT_ML + 2048;
__device__ __forceinline__ void attn_run(Frame& F, int u0, int cnt) {
    const int tid = F.tid, lane = F.lane, wave = F.wave, cl = lane & 15, g = lane >> 4, qt = wave & 3, kh = wave >> 2;
    LAS unsigned char* Ks = F.lds + ATT_K; LAS unsigned char* Vs = F.lds + ATT_V; LAS float* biasR = (LAS float*)(F.lds + ATT_BIAS); LAS float* mlL = (LAS float*)(F.lds + ATT_ML);
    const int ch = tid & 7, kl = tid >> 3;
    const f32x4 kg0 = *(const f32x4*)(F.k_gain + 8 * ch), kg1 = *(const f32x4*)(F.k_gain + 8 * ch + 4);
    const f32x4 ga = *(const f32x4*)(F.q_gain + 8 * g), gb = *(const f32x4*)(F.q_gain + 8 * g + 4), gc2 = *(const f32x4*)(F.q_gain + 32 + 8 * g), gd = *(const f32x4*)(F.q_gain + 32 + 8 * g + 4);
    int cur_bh = -1;
    u32x4 qn0 = {0u, 0u, 0u, 0u}, qn1 = {0u, 0u, 0u, 0u};
#pragma unroll 1
    for (int k = 0; k < cnt; ++k) {
        const int u = u0 + k, bh = u >> 7, c = u & (NCH - 1), b = bh >> 3, h = bh & 7;
        const size_t row0 = (size_t)b * SEQ + (size_t)c * 64;
        if (bh != cur_bh) {
            cur_bh = bh;
            float mq = 0.f, mk = 0.f, bmax = -1e30f;
#pragma unroll 8
            for (int d = 0; d < 64; ++d) { mq = fmaxf(mq, fabsf(F.q_gain[d])); mk = fmaxf(mk, fabsf(F.k_gain[d])); }
            for (int i = tid; i < 320; i += NTHR) bmax = fmaxf(bmax, F.rel_bias[h * 513 + 193 + i]);
#pragma unroll
            for (int o = 1; o < 64; o <<= 1) bmax = fmaxf(bmax, __shfl_xor(bmax, o));
            LAS float* bx = (LAS float*)(F.lds + ATT_SCR + 8192);
            if (lane == 0) bx[wave] = bmax;
            LDSBAR();
#pragma unroll
            for (int w8 = 0; w8 < 8; ++w8) bmax = fmaxf(bmax, bx[w8]);
            const float M2 = (8.0f * mq * mk + bmax) * LOG2E;
            for (int i = tid; i < 4 * 324; i += NTHR) { const int sidx = i / 324, y = i - sidx * 324; int x = 516 - y + sidx; x = x > 512 ? 512 : x; biasR[i] = F.rel_bias[h * 513 + x] * LOG2E - M2; }
#pragma unroll 9
            for (int j = 0; j < 9; ++j) {
                const int gc = c - 8 + j, key = ((gc + 9) % 9) * 64 + kl;
                u32x4 kw = {0u, 0u, 0u, 0u}, vw = {0u, 0u, 0u, 0u};
                if (gc >= 0) { const bf16* kp = F.PROJ + ((size_t)b * SEQ + (size_t)gc * 64 + kl) * NPROJ + 512 + h * 64 + 8 * ch; kw = *(const u32x4*)kp; vw = *(const u32x4*)(kp + 512); }
                attn_store_kv(Ks, Vs, key, ch, kw, vw, kg0, kg1);
            }
            { const bf16* qp = F.PROJ + (row0 + 16 * qt + cl) * NPROJ + h * 64 + 8 * g; qn0 = *(const u32x4*)qp; qn1 = *(const u32x4*)(qp + 32); }
            LDSBAR();
        }
        const bool has_next = (k + 1 < cnt) && (((u + 1) >> 7) == bh);
        u32x4 nk0 = {0u, 0u, 0u, 0u}, nv0 = nk0;
        const u32x4 q0 = qn0, q1 = qn1;
        if (has_next) {
            const bf16* kp = F.PROJ + ((size_t)b * SEQ + (size_t)(c + 1) * 64 + kl) * NPROJ + 512 + h * 64 + 8 * ch;
            nk0 = *(const u32x4*)kp; nv0 = *(const u32x4*)(kp + 512);
            const bf16* qp = F.PROJ + (row0 + 64 + 16 * qt + cl) * NPROJ + h * 64 + 8 * g; qn0 = *(const u32x4*)qp; qn1 = *(const u32x4*)(qp + 32);
        }
        bf16x8 Bq0, Bq1;
        {
            float qv[16];
#pragma unroll
            for (int e = 0; e < 4; ++e) { qv[2 * e] = bflo(q0[e]); qv[2 * e + 1] = bfhi(q0[e]); qv[8 + 2 * e] = bflo(q1[e]); qv[8 + 2 * e + 1] = bfhi(q1[e]); }
            float ss = 0.f;
#pragma unroll
            for (int e = 0; e < 16; ++e) ss += qv[e] * qv[e];
            ss += __shfl_xor(ss, 16); ss += __shfl_xor(ss, 32);
            const float rq = frsq(ss * (1.0f / 64) + EPS) * (0.125f * LOG2E);
            u32x4 p0, p1;
            p0.x = cvtpk(qv[0] * rq * ga[0], qv[1] * rq * ga[1]); p0.y = cvtpk(qv[2] * rq * ga[2], qv[3] * rq * ga[3]); p0.z = cvtpk(qv[4] * rq * gb[0], qv[5] * rq * gb[1]); p0.w = cvtpk(qv[6] * rq * gb[2], qv[7] * rq * gb[3]);
            p1.x = cvtpk(qv[8] * rq * gc2[0], qv[9] * rq * gc2[1]); p1.y = cvtpk(qv[10] * rq * gc2[2], qv[11] * rq * gc2[3]); p1.z = cvtpk(qv[12] * rq * gd[0], qv[13] * rq * gd[1]); p1.w = cvtpk(qv[14] * rq * gd[2], qv[15] * rq * gd[3]);
            Bq0 = __builtin_bit_cast(bf16x8, p0); Bq1 = __builtin_bit_cast(bf16x8, p1);
        }
        const int s0 = (c + 1) % 9, T0 = 18 * kh;
        const int off0 = (g ^ (cl & 7)) << 4, off1 = ((4 + g) ^ (cl & 7)) << 4;
        const int qi = 16 * qt + cl, sb3 = cl & 3;
        const LAS float* Rs = biasR + sb3 * 324;
        const int base0 = 768 + qi - 4 * g - sb3 - 16 * T0;
        f32x4 st[18];
#pragma unroll
        for (int t = 0; t < 18; ++t) {
            const int T = T0 + t, j = T >> 2; int sl = s0 + j; sl = sl >= 9 ? sl - 9 : sl;
            const LAS unsigned char* kb = Ks + (sl * 64 + (T & 3) * 16 + cl) * 128;
            const bf16x8 a0 = *(const LAS bf16x8*)(kb + off0), a1 = *(const LAS bf16x8*)(kb + off1);
            int b4 = base0 - 16 * t; b4 = b4 > 516 ? 516 : b4;
            f32x4 z = *(const LAS f32x4*)(Rs + (516 - b4));
            z = MFMA16(a0, Bq0, z); st[t] = MFMA16(a1, Bq1, z);
        }
        if (c < 8) {
#pragma unroll
            for (int t = 0; t < 18; ++t) if (c - 8 + ((T0 + t) >> 2) < 0) st[t] = (f32x4){-1e30f, -1e30f, -1e30f, -1e30f};
        }
        float lsum = 0.f;
#pragma unroll
        for (int t = 0; t < 18; ++t)
#pragma unroll
            for (int i = 0; i < 4; ++i) { const float p = __builtin_amdgcn_exp2f(st[t][i]); st[t][i] = p; lsum += p; }
        lsum += __shfl_xor(lsum, 16); lsum += __shfl_xor(lsum, 32);
        f32x4 o[4];
#pragma unroll
        for (int dt = 0; dt < 4; ++dt) o[dt] = (f32x4){0.f, 0.f, 0.f, 0.f};
        {
            const int q4 = cl >> 2, p4 = cl & 3, sw = (2 * g + (q4 >> 1)) & 3;
#pragma unroll
            for (int ks = 0; ks < 9; ++ks) {
                const int T = T0 + 2 * ks, j = T >> 2; int sl = s0 + j; sl = sl >= 9 ? sl - 9 : sl;
                const LAS unsigned char* vb = Vs + (sl * 64 + (T & 3) * 16 + 4 * g + q4) * 128 + 8 * p4;
                const bf16x8 pb = pack8(st[2 * ks], st[2 * ks + 1]);
#pragma unroll
                for (int dt = 0; dt < 4; ++dt) {
                    const v4i16_t lo = vtr(vb + ((dt ^ sw) << 5)), hi = vtr(vb + 2048 + ((dt ^ sw) << 5));
                    const bf16x8 a = __builtin_shufflevector(lo, hi, 0, 1, 2, 3, 4, 5, 6, 7);
                    o[dt] = MFMA16(a, pb, o[dt]);
                }
            }
        }
        LAS unsigned* scr = (LAS unsigned*)(F.lds + ATT_SCR);
        if (kh == 1) {
#pragma unroll
            for (int dt = 0; dt < 2; ++dt) { scr[(qt * 8 + 2 * dt) * 64 + lane] = cvtpk(o[dt][0], o[dt][1]); scr[(qt * 8 + 2 * dt + 1) * 64 + lane] = cvtpk(o[dt][2], o[dt][3]); }
        } else {
#pragma unroll
            for (int dt = 2; dt < 4; ++dt) { scr[(qt * 8 + 2 * dt) * 64 + lane] = cvtpk(o[dt][0], o[dt][1]); scr[(qt * 8 + 2 * dt + 1) * 64 + lane] = cvtpk(o[dt][2], o[dt][3]); }
        }
        mlL[kh * 256 + qt * 64 + lane] = lsum;
        LDSBAR();
        {
            const float l1 = mlL[(1 - kh) * 256 + qt * 64 + lane];
            const float inv = frcp(lsum + l1);
            bf16* op = F.OATT + (row0 + qi) * 512 + h * 64 + 4 * g;
            if (kh == 0) {
#pragma unroll
                for (int dt = 0; dt < 2; ++dt) {
                    const unsigned w0 = scr[(qt * 8 + 2 * dt) * 64 + lane], w1 = scr[(qt * 8 + 2 * dt + 1) * 64 + lane];
                    u32x2 w; w.x = cvtpk((o[dt][0] + bflo(w0)) * inv, (o[dt][1] + bfhi(w0)) * inv); w.y = cvtpk((o[dt][2] + bflo(w1)) * inv, (o[dt][3] + bfhi(w1)) * inv);
                    *(u32x2*)(op + 16 * dt) = w;
                }
            } else {
#pragma unroll
                for (int dt = 2; dt < 4; ++dt) {
                    const unsigned w0 = scr[(qt * 8 + 2 * dt) * 64 + lane], w1 = scr[(qt * 8 + 2 * dt + 1) * 64 + lane];
                    u32x2 w; w.x = cvtpk((o[dt][0] + bflo(w0)) * inv, (o[dt][1] + bfhi(w0)) * inv); w.y = cvtpk((o[dt][2] + bflo(w1)) * inv, (o[dt][3] + bfhi(w1)) * inv);
                    *(u32x2*)(op + 16 * dt) = w;
                }
            }
        }
        if (has_next) attn_store_kv(Ks, Vs, s0 * 64 + kl, ch, nk0, nv0, kg0, kg1);
        LDSBAR();
    }
}
__device__ __forceinline__ void attn_static(Frame& F, int ab, int nab) {
    const int total = BATCH * 8 * NCH;
    int start, cnt;
    if (nab == 224) {
        const int bh = ab / 14, r = ab - bh * 14;
        start = bh * NCH + r * 9 + (r < 2 ? r : 2); cnt = 9 + (r < 2 ? 1 : 0);
    } else {
        const int base = total / nab, rem = total % nab;
        start = ab * base + (ab < rem ? ab : rem); cnt = base + (ab < rem ? 1 : 0);
    }
    attn_run(F, start, cnt);
}

#define RLX_AGENT __ATOMIC_RELAXED, __HIP_MEMORY_SCOPE_AGENT
#define XB_TMO      128
#define XB_XCNT(j)  (256  + 64 * (j))
#define XB_XSUB(j)  (1280 + 64 * (j))
#define XB_XGEN(j)  (2304 + 64 * (j))
#define XB_TOP      3328
#define XB_TOPGEN   3392
#define XCD_BAR_WORDS 3456
#define XB_SPIN_CAP (1u << 18)

__device__ __forceinline__ unsigned xb_ld(unsigned* p)              { return __hip_atomic_load(p, __ATOMIC_RELAXED, __HIP_MEMORY_SCOPE_AGENT); }
__device__ __forceinline__ unsigned xb_add(unsigned* p, unsigned v) { return __hip_atomic_fetch_add(p, v, __ATOMIC_RELAXED, __HIP_MEMORY_SCOPE_AGENT); }
__device__ __forceinline__ unsigned xb_xcc_id() { return (unsigned)__builtin_amdgcn_s_getreg((3 << 11) | 20) & 0xFu; }
#define XB_SPIN(cond, bar) do { unsigned _sp = 0; while (cond) { __builtin_amdgcn_s_sleep(1); \
    if ((++_sp & 255u) == 0u) { if (xb_ld(&(bar)[XB_TMO])) break; if (_sp > XB_SPIN_CAP) { atomicAdd(&(bar)[XB_TMO], 1u); break; } } } } while (0)

struct XcdBarrier {
    unsigned* bar; unsigned x;
    volatile LAS unsigned* st;
};

__device__ __forceinline__ XcdBarrier xcd_barrier_post(unsigned* bar, volatile LAS unsigned* st) {
    XcdBarrier b; b.bar = bar; b.x = xb_xcc_id(); b.st = st;
    if (threadIdx.x == 0) (void)xb_add(&bar[XB_XCNT(b.x)], 1u);
    return b;
}
__device__ __forceinline__ void xcd_barrier_complete(unsigned* bar, unsigned x, unsigned& nloc, unsigned& nx) {
    const unsigned G = gridDim.x * gridDim.y * gridDim.z;
    unsigned sum, cnt, mine, sp = 0u;
    for (;;) {
        sum = 0u; cnt = 0u; mine = 0u;
#pragma unroll
        for (unsigned j = 0; j < 16; ++j) { const unsigned c = xb_ld(&bar[XB_XCNT(j)]); sum += c; cnt += (c > 0u) ? 1u : 0u; mine = (j == x) ? c : mine; }
        if (sum == G) break;
        __builtin_amdgcn_s_sleep(1);
        if ((++sp & 255u) == 0u) { if (xb_ld(&bar[XB_TMO])) break; if (sp > XB_SPIN_CAP) { atomicAdd(&bar[XB_TMO], 1u); break; } }
    }
    nloc = mine > 0u ? mine : 1u; nx = cnt > 0u ? cnt : 1u;
}

__device__ __forceinline__ void xcd_barrier(const XcdBarrier& b) {
    asm volatile("s_waitcnt vmcnt(0)" ::: "memory");
    __syncthreads();
    if (threadIdx.x == 0) {
        unsigned* bar = b.bar;
        __builtin_amdgcn_s_waitcnt(0);
        unsigned nloc = b.st[0], nx = b.st[1];
        if (nloc == 0u) { xcd_barrier_complete(bar, b.x, nloc, nx); b.st[0] = nloc; b.st[1] = nx; }
        const unsigned old = xb_add(&bar[XB_XSUB(b.x)], 1u);
        const unsigned gen = old / nloc;
        if (old + 1u == (gen + 1u) * nloc) {
            __builtin_amdgcn_fence(__ATOMIC_RELEASE, "agent");
            asm volatile("s_waitcnt vmcnt(0)" ::: "memory");
            const unsigned og = xb_add(&bar[XB_TOP], 1u);
            const unsigned tg = og / nx;
            if (og + 1u == (tg + 1u) * nx) xb_add(&bar[XB_TOPGEN], 1u);
            else XB_SPIN(xb_ld(&bar[XB_TOPGEN]) == tg, bar);
            __builtin_amdgcn_fence(__ATOMIC_ACQUIRE, "agent");
            xb_add(&bar[XB_XGEN(b.x)], 1u);
            asm volatile("s_waitcnt vmcnt(0)" ::: "memory");
        } else {
            XB_SPIN(xb_ld(&bar[XB_XGEN(b.x)]) == gen, bar);
            __builtin_amdgcn_fence(__ATOMIC_ACQUIRE, "agent");
            asm volatile("s_waitcnt vmcnt(0)" ::: "memory");
        }
    }
    __syncthreads();
}

#ifndef PROBE_DUP
#define PROBE_DUP -1
#endif
constexpr int N_PHASES = 8;
__global__ void __launch_bounds__(NTHR, 2) hymba_fwd(Args args) {
    extern __shared__ __attribute__((aligned(16))) unsigned char lds[];
    Frame F;
    F.lds = (LAS unsigned char*)lds;
    F.tid = threadIdx.x; F.lane = F.tid & 63; F.wave = __builtin_amdgcn_readfirstlane(F.tid >> 6);
    F.G = gridDim.x; F.gw = blockIdx.x * NWAVES + F.wave; F.NGW = F.G * NWAVES;
    F.x = args.in[0]; F.mix_gain = args.in[1]; F.w_in = args.in[2]; F.q_gain = args.in[3]; F.k_gain = args.in[4]; F.rel_bias = args.in[5]; F.att_out_gain = args.in[6];
    F.conv_w = args.in[7]; F.a_log = args.in[8]; F.dt_bias = args.in[9]; F.dn_out_gain = args.in[10]; F.w_out = args.in[11]; F.ffn_gain = args.in[12]; F.w1 = args.in[13]; F.w2 = args.in[14];
    F.out = args.out;
    unsigned char* ws = args.ws;
    F.WIN_T = (bf16*)(ws + WS_WIN); F.WOUT_T = (bf16*)(ws + WS_WOUT); F.W1_T = (bf16*)(ws + WS_W1); F.W2_T = (bf16*)(ws + WS_W2);
    F.GB = (float*)(ws + WS_GB); F.SSQ = (float*)(ws + WS_SSQ);
    F.XN = (bf16*)(ws + WS_XN); F.H1B = F.XN; F.WKI = F.XN;
    F.PROJ = (bf16*)(ws + WS_PROJ); F.MIX = (bf16*)(ws + WS_MIX); F.OATT = (bf16*)(ws + WS_OATT); F.Z = (bf16*)(ws + WS_Z);
    F.UI = (bf16*)(ws + WS_ODN); F.CD = (float*)(ws + WS_ODN + 16 * MiB); F.TinvI = (bf16*)(ws + WS_ODN + 24 * MiB);
    F.SnI = (bf16*)args.out; F.QdI = F.SnI + (size_t)16 * MiB; F.AttI = F.SnI + (size_t)24 * MiB;
    volatile LAS unsigned* MISC = (volatile LAS unsigned*)(F.lds + LDS_BYTES - 64);
    if (F.tid < 16) MISC[F.tid] = 0u;
    __syncthreads();
    XcdBarrier bar = xcd_barrier_post((unsigned*)(args.ws + WS_CTL) + 1024, MISC + 8);
    const int lo = args.ph_lo, hi = args.ph_hi;
#define IN(k) (lo <= (k) && (k) < hi)
#define SEAM(k) do { if (IN(k) && IN((k) + 1)) xcd_barrier(bar); } while (0)

    if (IN(0)) { p0_prologue(F); if (PROBE_DUP == 0) { xcd_barrier(bar); p0_prologue(F); } }
    SEAM(0);
    if (PROBE_DUP == 9) { xcd_barrier(bar); xcd_barrier(bar); xcd_barrier(bar); xcd_barrier(bar); }
    if (IN(1)) {
        pg8::Gemm g{F.XN, F.WIN_T, M, NPROJ, D}; pg8::StaticOrder S; S.init(M, NPROJ, F.G, (int)blockIdx.x);
        pg8::EpiBf16<0> E{F.PROJ, NPROJ, nullptr, 0, 0, 1.f};
        pg8::gemm_phase<pg8::EpiBf16<0>, pg8::StaticOrder, true, true>(F.lds, g, S, E);
        if (F.G == 256 && blockIdx.x >= 128) weights_rest(F, ((int)blockIdx.x - 128) * NWAVES + F.wave, 128 * NWAVES);
        if (PROBE_DUP == 1) { xcd_barrier(bar); pg8::gemm_phase<pg8::EpiBf16<0>, pg8::StaticOrder, true, true>(F.lds, g, S, E); }
    }
    SEAM(1);
    if (IN(2)) { for (int u = blockIdx.x; u < 1024; u += F.G) dn_prep_unit(F, u); if (PROBE_DUP == 2) { xcd_barrier(bar); for (int u = blockIdx.x; u < 1024; u += F.G) dn_prep_unit(F, u); } }
    SEAM(2);
    if (IN(3)) { if (PROBE_DUP == 8) { attn_static(F, (int)blockIdx.x, F.G); xcd_barrier(bar); if (blockIdx.x < 32) dn_scan(F, (int)blockIdx.x); } else if (blockIdx.x < 32) dn_scan(F, (int)blockIdx.x); else attn_static(F, (int)blockIdx.x - 32, F.G - 32); if (PROBE_DUP == 3) { xcd_barrier(bar); attn_static(F, (int)blockIdx.x, F.G); } }
    SEAM(3);
    if (IN(4)) { for (int t = F.gw; t < 4096; t += F.NGW) dn_out_task(F, t); finalize_att_rows(F); if (PROBE_DUP == 4) { xcd_barrier(bar); for (int t = F.gw; t < 4096; t += F.NGW) dn_out_task(F, t); finalize_att_rows(F); } }
    SEAM(4);
    if (IN(5)) {
        pg8::Gemm g{F.MIX, F.WOUT_T, M, D, D}; pg8::StaticOrder S; S.init(M, D, F.G, (int)blockIdx.x);
        pg8::EpiResid E{F.x, nullptr, F.H1B, F.SSQ, D};
        pg8::gemm_phase<pg8::EpiResid, pg8::StaticOrder, false, true>(F.lds, g, S, E);
        if (PROBE_DUP == 5) { xcd_barrier(bar); pg8::gemm_phase<pg8::EpiResid, pg8::StaticOrder, false, true>(F.lds, g, S, E); }
    }
    SEAM(5);
    if (IN(6)) {
        pg8::Gemm g{F.H1B, F.W1_T, M, FF, D}; pg8::StaticOrder S; S.init(M, FF, F.G, (int)blockIdx.x);
        pg8::EpiRelu2 E{F.Z, FF, F.SSQ, 1.0f / D, EPS};
        pg8::gemm_phase<pg8::EpiRelu2, pg8::StaticOrder, true, true>(F.lds, g, S, E);
        if (PROBE_DUP == 6) { xcd_barrier(bar); pg8::gemm_phase<pg8::EpiRelu2, pg8::StaticOrder, true, true>(F.lds, g, S, E); }
    }
    SEAM(6);
    if (IN(7)) {
        pg8::Gemm g{F.Z, F.W2_T, M, D, FF}; pg8::StaticOrder S; S.init(M, D, F.G, (int)blockIdx.x);
        pg8::EpiOutBf E{F.H1B, F.out, D};
        pg8::gemm_phase<pg8::EpiOutBf, pg8::StaticOrder, false, true>(F.lds, g, S, E);
    }
#undef IN
#undef SEAM
}

#ifndef MK_N_LAUNCHES
#define MK_N_LAUNCHES 1
#endif
extern "C" void kernel_launch(void* const* d_in, const int* in_sizes, int n_in, void* d_out, int out_size, void* d_ws, size_t ws_size, hipStream_t stream) {
    static int grid = 0;
    if (grid == 0) {
        if (n_in != 15 || in_sizes[0] != M * D || out_size != M * D || ws_size < WS_END) { fprintf(stderr, "kernel_launch: unexpected shapes (n_in %d, in0 %d, out %d, ws %zu); nothing launched\n", n_in, n_in > 0 ? in_sizes[0] : -1, out_size, ws_size); grid = -1; return; }
        int dev = 0, cus = 0, per_cu = 0;
        if (hipGetDevice(&dev) != hipSuccess || hipDeviceGetAttribute(&cus, hipDeviceAttributeMultiprocessorCount, dev) != hipSuccess) { grid = -1; return; }
        if (hipFuncSetAttribute((const void*)hymba_fwd, hipFuncAttributeMaxDynamicSharedMemorySize, LDS_BYTES) != hipSuccess) { fprintf(stderr, "kernel_launch: hipFuncSetAttribute failed\n"); grid = -1; return; }
        if (hipOccupancyMaxActiveBlocksPerMultiprocessor(&per_cu, (const void*)hymba_fwd, NTHR, LDS_BYTES) != hipSuccess || per_cu < 1) { fprintf(stderr, "kernel_launch: occupancy query says %d blocks per CU\n", per_cu); (void)hipGetLastError(); per_cu = 1; }
        grid = cus * (per_cu > 1 ? 1 : per_cu);
        if (grid > 256) grid = 256;
    }
    if (grid < 0) return;
    if (hipMemsetAsync((char*)d_ws + WS_CTL, 0, 65536, stream) != hipSuccess) { fprintf(stderr, "kernel_launch: memset failed\n"); return; }
    Args a{};
    for (int i = 0; i < 15; ++i) a.in[i] = (const float*)d_in[i];
    a.out = (float*)d_out; a.ws = (unsigned char*)d_ws;
#if MK_N_LAUNCHES == 1
    a.ph_lo = 0; a.ph_hi = N_PHASES;
    void* kargs[] = {&a};
    hipError_t e = hipLaunchCooperativeKernel((const void*)hymba_fwd, dim3(grid), dim3(NTHR), kargs, LDS_BYTES, stream);
    if (e != hipSuccess) fprintf(stderr, "kernel_launch: cooperative launch failed: %s (grid %d)\n", hipGetErrorString(e), grid);
#else
    for (int p = 0; p < N_PHASES; ++p) { a.ph_lo = p; a.ph_hi = p + 1; hipLaunchKernelGGL(hymba_fwd, dim3(grid), dim3(NTHR), LDS_BYTES, stream, a); }
#endif
}
```
